# Optimizing an MI355X kernel written in HIP

```python
import math
import jax, jax.numpy as jnp
from jax import lax
import numpy as np

D_MODEL = 2048
BATCH = 4
SEQ = 2048
DEPTH = 2

CHUNK = 64
N_META = 16
Q_BLOCK = 128
HEAD_DIM = 64
EPS = 1e-6
NEG = -1e30

A_HEADS = 16
A_KV_HEADS = 4
A_GROUP = A_HEADS // A_KV_HEADS
WINDOW = 128
WINDOW_CHUNKS = WINDOW // CHUNK
BAND_BACK = WINDOW + CHUNK
BAND_LEN = BAND_BACK + Q_BLOCK + CHUNK

B_HEADS = 16

C_HEADS = D_MODEL // (2 * HEAD_DIM)

D_FF = 4 * D_MODEL

N_EVEN = (DEPTH + 1) // 2
N_ODD = DEPTH // 2

A_Q = A_HEADS * HEAD_DIM
A_KV = A_KV_HEADS * HEAD_DIM
B_W = B_HEADS * HEAD_DIM
AB_IN = A_Q + 2 * A_KV + 3 * B_W
AB_OUT = A_Q + B_W
AB_SPLITS = [A_Q, A_Q + A_KV, A_Q + 2 * A_KV, A_Q + 2 * A_KV + B_W, A_Q + 2 * A_KV + 2 * B_W]
C_QK = C_HEADS * 2 * HEAD_DIM
C_IN = 3 * C_QK
C_OUT = C_HEADS * 2 * HEAD_DIM

kernel_name = "chunk_causal_hybrid_swa_sink_stickbreak_diffattn"


def rmsnorm(x, g):
    x32 = x.astype(jnp.float32)
    y = x32 * lax.rsqrt(jnp.mean(x32 * x32, axis=-1, keepdims=True) + EPS)
    return (y * g.astype(jnp.float32)).astype(x.dtype)


def chunk_id(pos):
    return jnp.where(pos < N_META, 0, 1 + (pos - N_META) // CHUNK)


def chunk_end(p):
    if p < N_META:
        return N_META
    return N_META + ((p - N_META) // CHUNK + 1) * CHUNK


def alibi_slopes(n):
    return jnp.exp2(-8.0 * (jnp.arange(n, dtype=jnp.float32) + 1.0) / n)


def sliding_sink_attention(q, k, v, sinks):
    bsz, lp = q.shape[0], q.shape[1]
    nb = lp // Q_BLOCK
    scale = HEAD_DIM ** -0.5
    qb = q.reshape(bsz, nb, Q_BLOCK, A_KV_HEADS, A_GROUP, HEAD_DIM)
    q_pos = jnp.arange(lp).reshape(nb, Q_BLOCK)
    k_pos = q_pos[:, :1] - BAND_BACK + jnp.arange(BAND_LEN)[None, :]
    k_idx = jnp.clip(k_pos, 0, lp - 1)
    kb = k[:, k_idx]
    vb = v[:, k_idx]
    km, vm = k[:, :N_META], v[:, :N_META]

    s_meta = jnp.einsum('bnqhgd,bmhd->bnhgqm', qb, km).astype(jnp.float32)
    s_band = jnp.einsum('bnqhgd,bnkhd->bnhgqk', qb, kb).astype(jnp.float32)
    s = jnp.concatenate([s_meta, s_band], axis=-1) * scale

    meta_pos = jnp.broadcast_to(jnp.arange(N_META)[None, :], (nb, N_META))
    kpos_all = jnp.concatenate([meta_pos, k_pos], axis=-1)
    qc = chunk_id(q_pos)[:, :, None]
    kc = chunk_id(k_pos)[:, None, :]
    band_ok = (k_pos[:, None, :] >= N_META) & (k_pos[:, None, :] < lp) & (kc <= qc) & (kc >= qc - WINDOW_CHUNKS)
    mask = jnp.concatenate([jnp.ones((nb, Q_BLOCK, N_META), bool), band_ok], axis=-1)
    dist = jnp.abs(q_pos[:, :, None] - kpos_all[:, None, :]).astype(jnp.float32)
    slopes = alibi_slopes(A_HEADS).reshape(A_KV_HEADS, A_GROUP)
    bias = -slopes[None, :, :, None, None] * dist[:, None, None]
    s = jnp.where(mask[None, :, None, None], s + bias[None], NEG)

    sink = sinks.astype(jnp.float32).reshape(A_KV_HEADS, A_GROUP)[None, None, :, :, None, None]
    sink = jnp.broadcast_to(sink, s.shape[:-1] + (1,))
    p = jax.nn.softmax(jnp.concatenate([s, sink], axis=-1), axis=-1)[..., :-1].astype(v.dtype)
    o = (jnp.einsum('bnhgqm,bmhd->bnqhgd', p[..., :N_META], vm)
         + jnp.einsum('bnhgqk,bnkhd->bnqhgd', p[..., N_META:], vb))
    return o.reshape(bsz, lp, A_HEADS * HEAD_DIM)


def stick_breaking_attention(q, k, v):
    lp = q.shape[1]
    scale = HEAD_DIM ** -0.5
    outs = []
    for q0 in range(0, lp, Q_BLOCK):
        q1 = q0 + Q_BLOCK
        z = jnp.einsum('bqhd,bkhd->bhqk', q[:, q0:q1], k[:, :q1]).astype(jnp.float32) * scale
        t_pos = jnp.arange(q0, q1)[:, None]
        s_pos = jnp.arange(q1)[None, :]
        strict = s_pos < t_pos
        log_keep = jnp.where(strict, jax.nn.log_sigmoid(-z), 0.0)
        between = lax.cumsum(log_keep, axis=3, reverse=True) - log_keep
        w = jnp.where(strict, jnp.exp(jax.nn.log_sigmoid(z) + between), 0.0)
        outs.append(jnp.einsum('bhqk,bkhd->bqhd', w.astype(v.dtype), v[:, :q1]))
    o = jnp.concatenate(outs, axis=1)
    return o.reshape(o.shape[0], lp, B_HEADS * HEAD_DIM)


def differential_attention(q, k, v, lam_vecs, subln_g, lambda_init):
    bsz, lp = q.shape[0], q.shape[1]
    scale = HEAD_DIM ** -0.5
    lv = lam_vecs.astype(jnp.float32)
    lam = jnp.exp(jnp.sum(lv[0] * lv[1])) - jnp.exp(jnp.sum(lv[2] * lv[3])) + lambda_init
    slopes = alibi_slopes(C_HEADS)
    outs = []
    for q0 in range(0, lp, Q_BLOCK):
        q1 = q0 + Q_BLOCK
        kend = min(lp, chunk_end(q1 - 1))
        s = jnp.einsum('bqhcd,bkhcd->bhcqk', q[:, q0:q1], k[:, :kend]).astype(jnp.float32) * scale
        qp = jnp.arange(q0, q1)
        kp = jnp.arange(kend)
        mask = chunk_id(kp)[None, :] <= chunk_id(qp)[:, None]
        dist = jnp.abs(qp[:, None] - kp[None, :]).astype(jnp.float32)
        bias = -slopes[:, None, None, None] * dist[None, None]
        s = jnp.where(mask, s + bias, NEG)
        p = jax.nn.softmax(s, axis=-1)
        w = (p[:, :, 0] - lam * p[:, :, 1]).astype(v.dtype)
        outs.append(jnp.einsum('bhqk,bkhe->bqhe', w, v[:, :kend]))
    o = jnp.concatenate(outs, axis=1)
    o = rmsnorm(o, subln_g) * (1.0 - lambda_init)
    return o.reshape(bsz, lp, C_HEADS * 2 * HEAD_DIM)


def setup_inputs(seed: int = 0) -> dict:
    key = jax.random.key(seed)
    ks = jax.random.split(key, 16)
    f32 = jnp.float32

    def dense(k, shape, fan_in):
        return jax.random.normal(k, shape, f32) * fan_in ** -0.5

    def gain(k, shape):
        return 1.0 + 0.02 * jax.random.normal(k, shape, f32)

    return {
        "x": jax.random.normal(ks[0], (BATCH, SEQ, D_MODEL), f32),
        "meta_tokens": jax.random.normal(ks[1], (N_META, D_MODEL), f32),
        "ab_norm": gain(ks[2], (N_EVEN, D_MODEL)),
        "w_in_ab": dense(ks[3], (N_EVEN, D_MODEL, AB_IN), D_MODEL),
        "attn_sinks": jax.random.normal(ks[4], (N_EVEN, A_HEADS), f32),
        "w_out_ab": dense(ks[5], (N_EVEN, AB_OUT, D_MODEL), AB_OUT),
        "c_norm": gain(ks[6], (N_ODD, D_MODEL)),
        "w_in_c": dense(ks[7], (N_ODD, D_MODEL, C_IN), D_MODEL),
        "diff_lambda": 0.1 * jax.random.normal(ks[8], (N_ODD, 4, HEAD_DIM), f32),
        "diff_subln": gain(ks[9], (N_ODD, 2 * HEAD_DIM)),
        "w_out_c": dense(ks[10], (N_ODD, C_OUT, D_MODEL), C_OUT),
        "mlp_norm": gain(ks[11], (DEPTH, D_MODEL)),
        "w_mlp_in": dense(ks[12], (DEPTH, D_MODEL, D_FF), D_MODEL),
        "w_mlp_out": dense(ks[13], (DEPTH, D_FF, D_MODEL), D_FF),
        "final_norm": gain(ks[14], (D_MODEL,)),
    }


def reference(x, meta_tokens, ab_norm, w_in_ab, attn_sinks, w_out_ab, c_norm, w_in_c,
              diff_lambda, diff_subln, w_out_c, mlp_norm, w_mlp_in, w_mlp_out, final_norm):
    bsz, seq = x.shape[0], x.shape[1]
    total = N_META + seq
    lp = ((total + Q_BLOCK - 1) // Q_BLOCK) * Q_BLOCK
    meta = jnp.broadcast_to(meta_tokens.astype(x.dtype)[None], (bsz, N_META, D_MODEL))
    h = jnp.concatenate([meta, x], axis=1)
    h = jnp.pad(h, ((0, 0), (0, lp - total), (0, 0)))

    for layer in range(DEPTH):
        if layer % 2 == 0:
            i = layer // 2
            hn = rmsnorm(h, ab_norm[i])
            proj = hn @ w_in_ab[i]
            qa, ka, va, qb, kb, vb = jnp.split(proj, AB_SPLITS, axis=-1)
            out_a = sliding_sink_attention(
                qa.reshape(bsz, lp, A_HEADS, HEAD_DIM),
                ka.reshape(bsz, lp, A_KV_HEADS, HEAD_DIM),
                va.reshape(bsz, lp, A_KV_HEADS, HEAD_DIM),
                attn_sinks[i])
            out_b = stick_breaking_attention(
                qb.reshape(bsz, lp, B_HEADS, HEAD_DIM),
                kb.reshape(bsz, lp, B_HEADS, HEAD_DIM),
                vb.reshape(bsz, lp, B_HEADS, HEAD_DIM))
            h = h + jnp.concatenate([out_a, out_b], axis=-1) @ w_out_ab[i]
        else:
            i = layer // 2
            lambda_init = 0.8 - 0.6 * math.exp(-0.3 * layer)
            hn = rmsnorm(h, c_norm[i])
            proj = hn @ w_in_c[i]
            qc, kc, vc = jnp.split(proj, 3, axis=-1)
            out_c = differential_attention(
                qc.reshape(bsz, lp, C_HEADS, 2, HEAD_DIM),
                kc.reshape(bsz, lp, C_HEADS, 2, HEAD_DIM),
                vc.reshape(bsz, lp, C_HEADS, 2 * HEAD_DIM),
                diff_lambda[i], diff_subln[i], lambda_init)
            h = h + out_c @ w_out_c[i]
        hn = rmsnorm(h, mlp_norm[layer])
        h = h + jnp.square(jax.nn.relu(hn @ w_mlp_in[layer])) @ w_mlp_out[layer]

    h = rmsnorm(h, final_norm)
    return h[:, N_META:N_META + seq]
```

```cpp
#include <hip/hip_runtime.h>
#include <hip/hip_cooperative_groups.h>
#include <cstdio>
#include <cstdint>
namespace cg = cooperative_groups;

constexpr int DM = 2048, NBATCH = 4, SEQ = 2048, NMETA = 16, LP = 2176, MROWS = NBATCH * LP, DFF = 8192;
constexpr int QKLD = 4096, VTLD = MROWS;
constexpr int LPR = NMETA + SEQ, RVALID = NBATCH * LPR  , MR = 8448  , NQT = (LPR + 31) / 32  ;
constexpr float RMS_EPS = 1e-6f;
constexpr float LOG2E_F = 1.4426950408889634f;

namespace pg8 {
#define PG8_LAS __attribute__((address_space(3)))
typedef unsigned short bf16_t;
typedef short bf16x8 __attribute__((ext_vector_type(8)));
typedef float f32x4 __attribute__((ext_vector_type(4)));
typedef unsigned u32x4 __attribute__((ext_vector_type(4)));
constexpr int BM = 256, BK = 64, HALF = 128, HTB = HALF * BK * 2  , STAGE_BYTES = 8 * HTB, NXCD = 8, WGM = 8;

__host__ __device__ __forceinline__ int lds_byte(int r, int c) { const int st = (r >> 4) * 2 + (c >> 5), rr = r & 15, cc = c & 31, ob = rr * 64 + cc * 2; return st * 1024 + (ob ^ (((ob >> 9) & 1) << 5)); }
__host__ __device__ __forceinline__ void stage_rc(int b, int& R, int& C) { const int st = b / 1024, sb = b % 1024, swz = sb ^ (((sb >> 9) & 1) << 5); R = (st >> 1) * 16 + swz / 64; C = (st & 1) * 32 + (swz % 64) / 2; }
__host__ __device__ __forceinline__ int perm32(int rho) { const int n = rho >> 4, i = rho & 15; return 8 * (i >> 2) + 4 * n + (i & 3); }

struct Unit { int pm, pn, which, k0, nt, part; };
struct Gemm { const bf16_t* A0; const bf16_t* B0; const bf16_t* A1; const bf16_t* B1; int K; };

struct DualOrder {
    int nM0, nN0, n0, nM1, nN1, n1, G, c, ntK;
    __device__ __forceinline__ void init(int M0, int N0, int M1, int N1, int K_, int G_, int c_) { ntK = K_ / BK; nM0 = M0 / BM; nN0 = N0 / BM; n0 = nM0 * nN0; nM1 = M1 / BM; nN1 = N1 / BM; n1 = nM1 * nN1; G = G_; c = c_; }
    __device__ __forceinline__ bool next(int i, Unit& u) const {
        const long L = (long)i * G + c; if (L >= n0 + n1) return false;
        int w = (int)L, nM, nN, nwg; u.k0 = 0; u.nt = ntK; u.part = -1;
        if (w < n0) { u.which = 0; nM = nM0; nN = nN0; nwg = n0; } else { u.which = 1; w -= n0; nM = nM1; nN = nN1; nwg = n1; }
        { const int q = nwg / NXCD, r = nwg % NXCD, xcd = w % NXCD, off = w / NXCD; w = (xcd < r ? xcd * (q + 1) : r * (q + 1) + (xcd - r) * q) + off; }
        const int nig = WGM * nN, gid = w / nig, fm = gid * WGM, gsz = (nM - fm) < WGM ? (nM - fm) : WGM;
        u.pm = fm + ((w % nig) % gsz); u.pn = (w % nig) / gsz; return true;
    }
    __device__ __forceinline__ void a_ready(const Unit&) const {}
    __device__ __forceinline__ void done(const Unit&) const {}
};

template <int lgS> struct TailSplitOrder {
    int G, c, K;
    __device__ __forceinline__ void init(int K_, int G_, int c_) { K = K_; G = G_; c = c_; }
    __device__ __forceinline__ bool next(int i, Unit& u) const {
        u.which = 0; u.pm = 0; u.pn = 0; u.k0 = 0; u.nt = 2; u.part = -1;
        const long L = (long)i * G + c; if (L >= 256 + (8 << lgS)) return false;
        if (L < 256) { int w = (int)L; { const int xcd = w % NXCD, off = w / NXCD; w = xcd * 32 + off; }
            const int nig = WGM * 8, gid = w / nig, fm = gid * WGM; u.pm = fm + ((w % nig) % WGM); u.pn = (w % nig) / WGM; u.k0 = 0; u.nt = K / BK; u.part = -1; }
        else { const int s = (int)L - 256, tile = s >> lgS, part = s & ((1 << lgS) - 1); u.pm = 32; u.pn = tile & 7; u.nt = (K / BK) >> lgS; u.k0 = part * (K >> lgS); u.part = part; }
        return true;
    }
    __device__ __forceinline__ void a_ready(const Unit&) const {}
    __device__ __forceinline__ void done(const Unit&) const {}
};

__device__ __forceinline__ unsigned cvt_pk_bf16(float lo, float hi) { unsigned r; asm volatile("v_cvt_pk_bf16_f32 %0, %1, %2" : "=v"(r) : "v"(lo), "v"(hi)); return r; }


__device__ __forceinline__ float row_ss(const float* ss, int row) {
    const f32x4* p = (const f32x4*)(ss + (size_t)row * 32);
    const f32x4 a = (p[0] + p[1]) + (p[2] + p[3]), b = (p[4] + p[5]) + (p[6] + p[7]), c = a + b;
    return (c[0] + c[1]) + (c[2] + c[3]);
}
struct EpiProj {
    static constexpr bool PERM = true, AFTER_DRAIN = false;
    bf16_t* O0; int ld0; bf16_t* O1; int ld1; const float* ss; const float* ssc; float* kmax; int kc0, kc1;
    __device__ __forceinline__ void operator()(const f32x4 (&acc)[2][2][4][2], const Unit& u, int wr, int wc, int fr, int fq) const {
        const int row0 = u.pm * BM + wr * 64 + fr, col0 = u.pn * BM + wc * 32 + 8 * fq;
        if (u.which == 0) {
            const bool want_k = kmax != nullptr && u.pn * BM >= kc0 && u.pn * BM < kc1;
            float km[2] = {0.f, 0.f};
#pragma unroll
            for (int ai = 0; ai < 2; ++ai)
#pragma unroll
                for (int m = 0; m < 4; ++m) { const int row = row0 + ai * HALF + m * 16; const float rs = rsqrtf((u.pm >= 32 ? row_ss(ss, row) : ssc[row]) * (1.0f / DM) + RMS_EPS);
                    bf16_t* rowp = O0 + (size_t)row * ld0 + col0;
#pragma unroll
                    for (int bj = 0; bj < 2; ++bj) { const f32x4 v0 = acc[ai][bj][m][0] * rs, v1 = acc[ai][bj][m][1] * rs;
                        u32x4 w; w.x = cvt_pk_bf16(v0[0], v0[1]); w.y = cvt_pk_bf16(v0[2], v0[3]); w.z = cvt_pk_bf16(v1[0], v1[1]); w.w = cvt_pk_bf16(v1[2], v1[3]);
                        *(u32x4*)(rowp + bj * HALF) = w;
                        if (want_k) { float q = (v0[0] * v0[0] + v0[1] * v0[1]) + (v0[2] * v0[2] + v0[3] * v0[3]) + (v1[0] * v1[0] + v1[1] * v1[1]) + (v1[2] * v1[2] + v1[3] * v1[3]);
                            q += __shfl_xor(q, 16); q += __shfl_xor(q, 32); km[bj] = fmaxf(km[bj], q); } } }
            if (want_k) {
#pragma unroll
                for (int bj = 0; bj < 2; ++bj) { float q = km[bj];
#pragma unroll
                    for (int o = 1; o < 16; o <<= 1) q = fmaxf(q, __shfl_xor(q, o));
                    if (fr == 0 && fq == 0) atomicMax((unsigned*)kmax + 2 * ((u.pn * BM + bj * HALF + wc * 32 - kc0) >> 6) + (wc & 1), __float_as_uint(q * 1.02f)); }
            }
        } else {
            f32x4 rs[2][2];
#pragma unroll
            for (int bj = 0; bj < 2; ++bj)
#pragma unroll
                for (int n = 0; n < 2; ++n) { const int tk = col0 + bj * HALF + 4 * n; const f32x4 s4 = u.pn >= 32 ? (f32x4){row_ss(ss, tk), row_ss(ss, tk + 1), row_ss(ss, tk + 2), row_ss(ss, tk + 3)} : *(const f32x4*)(ssc + tk);
                    rs[bj][n] = (f32x4){rsqrtf(s4[0] * (1.0f / DM) + RMS_EPS), rsqrtf(s4[1] * (1.0f / DM) + RMS_EPS), rsqrtf(s4[2] * (1.0f / DM) + RMS_EPS), rsqrtf(s4[3] * (1.0f / DM) + RMS_EPS)}; }
#pragma unroll
            for (int ai = 0; ai < 2; ++ai)
#pragma unroll
                for (int m = 0; m < 4; ++m) { const int row = row0 + ai * HALF + m * 16; bf16_t* rowp = O1 + (size_t)row * ld1 + col0;
#pragma unroll
                    for (int bj = 0; bj < 2; ++bj) { const f32x4 v0 = acc[ai][bj][m][0] * rs[bj][0], v1 = acc[ai][bj][m][1] * rs[bj][1];
                        u32x4 w; w.x = cvt_pk_bf16(v0[0], v0[1]); w.y = cvt_pk_bf16(v0[2], v0[3]); w.z = cvt_pk_bf16(v1[0], v1[1]); w.w = cvt_pk_bf16(v1[2], v1[3]);
                        *(u32x4*)(rowp + bj * HALF) = w; } }
        }
    }
};
struct EpiMlpUp {
    static constexpr bool PERM = true, AFTER_DRAIN = false;
    bf16_t* O; int ldc; const float* ss; const float* ssc;
    __device__ __forceinline__ void operator()(const f32x4 (&acc)[2][2][4][2], const Unit& u, int wr, int wc, int fr, int fq) const {
        const int row0 = u.pm * BM + wr * 64 + fr, col0 = u.pn * BM + wc * 32 + 8 * fq;
#pragma unroll
        for (int ai = 0; ai < 2; ++ai)
#pragma unroll
            for (int m = 0; m < 4; ++m) { const int row = row0 + ai * HALF + m * 16; const float rs = rsqrtf((u.pm >= 32 ? row_ss(ss, row) : ssc[row]) * (1.0f / DM) + RMS_EPS);
                bf16_t* rowp = O + (size_t)row * ldc + col0;
#pragma unroll
                for (int bj = 0; bj < 2; ++bj) { f32x4 v0 = acc[ai][bj][m][0] * rs, v1 = acc[ai][bj][m][1] * rs;
#pragma unroll
                    for (int e = 0; e < 4; ++e) { const float a = fmaxf(v0[e], 0.f), b = fmaxf(v1[e], 0.f); v0[e] = a * a; v1[e] = b * b; }
                    u32x4 w; w.x = cvt_pk_bf16(v0[0], v0[1]); w.y = cvt_pk_bf16(v0[2], v0[3]); w.z = cvt_pk_bf16(v1[0], v1[1]); w.w = cvt_pk_bf16(v1[2], v1[3]);
                    *(u32x4*)(rowp + bj * HALF) = w; } }
    }
};
template <int lgS> struct EpiResid {
    static constexpr bool PERM = true, AFTER_DRAIN = false;
    bf16_t* hb; float* ss; float* part;
    __device__ __forceinline__ void operator()(const f32x4 (&acc)[2][2][4][2], const Unit& u, int wr, int wc, int fr, int fq) const {
        if (u.part >= 0) {
            float* pp = part + ((size_t)(((((u.pm - 32) * 8 + u.pn) << lgS) + u.part)) << 16) + (size_t)(wr * 64 + fr) * BM + wc * 32 + 8 * fq;
#pragma unroll
            for (int ai = 0; ai < 2; ++ai)
#pragma unroll
                for (int m = 0; m < 4; ++m)
#pragma unroll
                    for (int bj = 0; bj < 2; ++bj) { float* q = pp + (size_t)(ai * HALF + m * 16) * BM + bj * HALF; __builtin_nontemporal_store(acc[ai][bj][m][0], (f32x4*)q); __builtin_nontemporal_store(acc[ai][bj][m][1], (f32x4*)(q + 4)); }
            return;
        }
        const int row0 = u.pm * BM + wr * 64 + fr, col0 = u.pn * BM + wc * 32 + 8 * fq;
#pragma unroll
        for (int ai = 0; ai < 2; ++ai)
#pragma unroll
            for (int m = 0; m < 4; ++m) { const int row = row0 + ai * HALF + m * 16;
                bf16_t* hp = hb + (size_t)row * DM + col0; float part = 0.f;
#pragma unroll
                for (int bj = 0; bj < 2; ++bj) {
                    const u32x4 o = *(const u32x4*)(hp + bj * HALF);
                    f32x4 h0 = {__uint_as_float(o.x << 16), __uint_as_float(o.x & 0xffff0000u), __uint_as_float(o.y << 16), __uint_as_float(o.y & 0xffff0000u)};
                    f32x4 h1 = {__uint_as_float(o.z << 16), __uint_as_float(o.z & 0xffff0000u), __uint_as_float(o.w << 16), __uint_as_float(o.w & 0xffff0000u)};
                    h0 += acc[ai][bj][m][0]; h1 += acc[ai][bj][m][1];
                    part += (h0[0] * h0[0] + h0[1] * h0[1]) + (h0[2] * h0[2] + h0[3] * h0[3]) + (h1[0] * h1[0] + h1[1] * h1[1]) + (h1[2] * h1[2] + h1[3] * h1[3]);
                    u32x4 w; w.x = cvt_pk_bf16(h0[0], h0[1]); w.y = cvt_pk_bf16(h0[2], h0[3]); w.z = cvt_pk_bf16(h1[0], h1[1]); w.w = cvt_pk_bf16(h1[2], h1[3]);
                    *(u32x4*)(hp + bj * HALF) = w; }
                part += __shfl_xor(part, 16); part += __shfl_xor(part, 32);
                if (fq == 0) ss[(size_t)row * 32 + u.pn * 4 + wc] = part; }
    }
};

template <class Epi, class Sched, bool ALIGN_EPI = false, bool SP2 = false>
__device__ __forceinline__ void gemm_phase(PG8_LAS unsigned char* lds, const Gemm g, const Sched& S, const Epi& E) {
    int tid_ = threadIdx.x; asm volatile("" : "+v"(tid_));
    const int tid = tid_, wid = __builtin_amdgcn_readfirstlane(tid >> 6), lane = tid & 63, wr = wid >> 2, wc = wid & 3, fr = lane & 15, fq = lane >> 4;
    const int K = g.K;
    unsigned voffA[2], voffB[2];
#pragma unroll
    for (int i = 0; i < 2; ++i) { int R, C; stage_rc(tid * 16 + i * 8192, R, C); const int Rb = Epi::PERM ? ((R & ~31) + perm32(R & 31)) : R;
        voffA[i] = (unsigned)(R * K + C) * 2u; voffB[i] = (unsigned)(Rb * K + C) * 2u; }
    const size_t kstep = (size_t)(BK * 2);
    const size_t hstep = (size_t)HALF * K * 2;
    const size_t tstep = 2 * hstep;
    const unsigned ldsw = (unsigned)wid * 1024u;
    const int aoff = lds_byte(wr * 64 + fr, fq * 8), boff = lds_byte(wc * 32 + fr, fq * 8);
#define PG8_SA(b, h) (((b) * 2 + (h)) * HTB)
#define PG8_SB(b, h) ((4 + (b) * 2 + (h)) * HTB)
#define PG8_STAGE(bufoff, gbase, voff) do { _Pragma("unroll") for (int _i = 0; _i < 2; ++_i) \
        __builtin_amdgcn_global_load_lds((const unsigned*)((const char*)(gbase) + (voff)[_i]), (PG8_LAS unsigned*)(lds + (bufoff) + ldsw + _i * 8192), 16, 0, 0); } while (0)
#define PG8_LDA(dst, b, h) do { _Pragma("unroll") for (int m = 0; m < 4; ++m) _Pragma("unroll") for (int k = 0; k < 2; ++k) dst[m][k] = *(const PG8_LAS bf16x8*)(lds + PG8_SA(b, h) + aoff + m * 2048 + k * 1024); } while (0)
#define PG8_LDB(dst, b, h) do { _Pragma("unroll") for (int n = 0; n < 2; ++n) _Pragma("unroll") for (int k = 0; k < 2; ++k) dst[n][k] = *(const PG8_LAS bf16x8*)(lds + PG8_SB(b, h) + boff + n * 2048 + k * 1024); } while (0)
#define PG8_MMA(ai, bj, At, Bt) do { __builtin_amdgcn_s_setprio(1); _Pragma("unroll") for (int m = 0; m < 4; ++m) _Pragma("unroll") for (int n = 0; n < 2; ++n) _Pragma("unroll") for (int k = 0; k < 2; ++k) \
        acc[ai][bj][m][n] = __builtin_amdgcn_mfma_f32_16x16x32_bf16(Bt[n][k], At[m][k], acc[ai][bj][m][n], 0, 0, 0); __builtin_amdgcn_s_setprio(0); } while (0)
#define PG8_WAIT_V(n) asm volatile("s_waitcnt vmcnt(" #n ")" ::: "memory")
#define PG8_WAIT_L(n) asm volatile("s_waitcnt lgkmcnt(" #n ")" ::: "memory")
#define PG8_BAR __builtin_amdgcn_s_barrier()
#define PG8_SCHED __builtin_amdgcn_sched_barrier(0)
    Unit cur, nxt; int ui = 0;
    if (!S.next(0, cur)) return;
    f32x4 acc[2][2][4][2];
#pragma unroll
    for (int a = 0; a < 2; ++a)
#pragma unroll
        for (int b = 0; b < 2; ++b)
#pragma unroll
            for (int m = 0; m < 4; ++m)
#pragma unroll
                for (int n = 0; n < 2; ++n) acc[a][b][m][n] = (f32x4){0.f, 0.f, 0.f, 0.f};
    bf16x8 At[4][2], B0[2][2], B1[2][2];
    const char* cA = (const char*)(cur.which ? g.A1 : g.A0) + (size_t)cur.pm * tstep + (size_t)cur.k0 * 2; const char* cB = (const char*)(cur.which ? g.B1 : g.B0) + (size_t)cur.pn * tstep + (size_t)cur.k0 * 2;
    S.a_ready(cur);
    if constexpr (SP2) {
        PG8_STAGE(PG8_SB(0, 0), cB, voffB); PG8_STAGE(PG8_SB(0, 1), cB + hstep, voffB); PG8_STAGE(PG8_SA(0, 0), cA, voffA); PG8_STAGE(PG8_SA(0, 1), cA + hstep, voffA);
        if (wr == 1) PG8_BAR;
        PG8_WAIT_V(2); PG8_BAR;
        PG8_STAGE(PG8_SB(1, 0), cB + kstep, voffB); PG8_STAGE(PG8_SA(1, 0), cA + kstep, voffA); PG8_STAGE(PG8_SB(1, 1), cB + hstep + kstep, voffB);
        PG8_WAIT_V(6); PG8_BAR;
    } else {
        PG8_STAGE(PG8_SB(0, 0), cB, voffB); PG8_STAGE(PG8_SA(0, 0), cA, voffA); PG8_STAGE(PG8_SB(0, 1), cB + hstep, voffB); PG8_STAGE(PG8_SA(0, 1), cA + hstep, voffA);
        if (wr == 1) PG8_BAR;
        PG8_WAIT_V(4); PG8_BAR;
        PG8_STAGE(PG8_SB(1, 0), cB + kstep, voffB); PG8_STAGE(PG8_SA(1, 0), cA + kstep, voffA); PG8_STAGE(PG8_SB(1, 1), cB + hstep + kstep, voffB);
        PG8_WAIT_V(6); PG8_BAR;
    }
    for (;;) {
        const bool has_next = S.next(ui + 1, nxt);
        const char* nA = has_next ? (const char*)(nxt.which ? g.A1 : g.A0) + (size_t)nxt.pm * tstep + (size_t)nxt.k0 * 2 : cA; const char* nB = has_next ? (const char*)(nxt.which ? g.B1 : g.B0) + (size_t)nxt.pn * tstep + (size_t)nxt.k0 * 2 : cB;
        const int nt = cur.nt;
        for (int t = 0; t < nt; t += 2) {
            const bool last = (t == nt - 2);
            const char* a1 = cA + (size_t)(t + 1) * kstep;
            const char* a2 = last ? nA : cA + (size_t)(t + 2) * kstep; const char* b2 = last ? nB : cB + (size_t)(t + 2) * kstep;
            const char* a3 = a2 + kstep; const char* b3 = b2 + kstep;
            if (last && has_next) S.a_ready(nxt);
            if constexpr (SP2) {
            PG8_LDB(B0, 0, 0); PG8_LDB(B1, 0, 1); PG8_SCHED; PG8_LDA(At, 0, 0); PG8_STAGE(PG8_SA(1, 1), a1 + hstep, voffA);
            PG8_WAIT_V(8); PG8_WAIT_L(0); PG8_BAR; PG8_MMA(0, 0, At, B0); PG8_MMA(0, 1, At, B1); PG8_BAR; PG8_SCHED;
            PG8_LDA(At, 0, 1); PG8_STAGE(PG8_SB(0, 0), b2, voffB); PG8_STAGE(PG8_SB(0, 1), b2 + hstep, voffB); PG8_STAGE(PG8_SA(0, 0), a2, voffA);
            PG8_WAIT_V(8); PG8_WAIT_L(0); PG8_BAR; PG8_MMA(1, 0, At, B0); PG8_MMA(1, 1, At, B1); PG8_BAR; PG8_SCHED;
            PG8_LDB(B0, 1, 0); PG8_LDB(B1, 1, 1); PG8_SCHED; PG8_LDA(At, 1, 0); PG8_STAGE(PG8_SA(0, 1), a2 + hstep, voffA);
            PG8_WAIT_V(8); PG8_WAIT_L(0); PG8_BAR; PG8_MMA(0, 0, At, B0); PG8_MMA(0, 1, At, B1); PG8_BAR; PG8_SCHED;
            PG8_LDA(At, 1, 1); PG8_STAGE(PG8_SB(1, 0), b3, voffB); PG8_STAGE(PG8_SB(1, 1), b3 + hstep, voffB); PG8_STAGE(PG8_SA(1, 0), a3, voffA);
            PG8_WAIT_V(8); PG8_WAIT_L(0); PG8_BAR; PG8_MMA(1, 0, At, B0); PG8_MMA(1, 1, At, B1); PG8_BAR; PG8_SCHED;
            } else {
            PG8_LDB(B0, 0, 0); PG8_SCHED; PG8_LDA(At, 0, 0); PG8_STAGE(PG8_SA(1, 1), a1 + hstep, voffA);
            PG8_WAIT_L(8); PG8_BAR; PG8_WAIT_L(0); PG8_MMA(0, 0, At, B0); PG8_BAR; PG8_SCHED;
            PG8_LDB(B1, 0, 1); PG8_STAGE(PG8_SB(0, 0), b2, voffB);
            PG8_BAR; PG8_WAIT_L(0); PG8_MMA(0, 1, At, B1); PG8_BAR;
            PG8_LDA(At, 0, 1); PG8_STAGE(PG8_SA(0, 0), a2, voffA);
            PG8_BAR; PG8_WAIT_L(0); PG8_MMA(1, 0, At, B0); PG8_BAR; PG8_SCHED;
            PG8_STAGE(PG8_SB(0, 1), b2 + hstep, voffB);
            PG8_WAIT_V(6); PG8_BAR; PG8_MMA(1, 1, At, B1); PG8_BAR;
            PG8_LDB(B0, 1, 0); PG8_SCHED; PG8_LDA(At, 1, 0); PG8_STAGE(PG8_SA(0, 1), a2 + hstep, voffA);
            PG8_WAIT_L(8); PG8_BAR; PG8_WAIT_L(0); PG8_MMA(0, 0, At, B0); PG8_BAR; PG8_SCHED;
            PG8_LDB(B1, 1, 1); PG8_STAGE(PG8_SB(1, 0), b3, voffB);
            PG8_BAR; PG8_WAIT_L(0); PG8_MMA(0, 1, At, B1); PG8_BAR;
            PG8_LDA(At, 1, 1); PG8_STAGE(PG8_SA(1, 0), a3, voffA);
            PG8_BAR; PG8_WAIT_L(0); PG8_MMA(1, 0, At, B0); PG8_BAR; PG8_SCHED;
            PG8_STAGE(PG8_SB(1, 1), b3 + hstep, voffB);
            PG8_WAIT_V(6); PG8_BAR; PG8_MMA(1, 1, At, B1); PG8_BAR;
            }
        }
        if constexpr (ALIGN_EPI) { if (wr == 0) PG8_BAR; }
        if constexpr (!Epi::AFTER_DRAIN) { E(acc, cur, wr, wc, fr, fq); S.done(cur); }
        if (!has_next) break;
#pragma unroll
        for (int a = 0; a < 2; ++a)
#pragma unroll
            for (int b = 0; b < 2; ++b)
#pragma unroll
                for (int m = 0; m < 4; ++m)
#pragma unroll
                    for (int n = 0; n < 2; ++n) acc[a][b][m][n] = (f32x4){0.f, 0.f, 0.f, 0.f};
        cur = nxt; cA = nA; cB = nB; ++ui;
        if constexpr (ALIGN_EPI) { if (wr == 1) PG8_BAR; }
    }
    PG8_WAIT_V(0);
    if constexpr (!ALIGN_EPI) { if (wr == 0) PG8_BAR; }
    PG8_BAR;
    if constexpr (Epi::AFTER_DRAIN) { E.fused(acc, cur, wr, wc, fr, fq, lds, wid, lane); S.done(cur); }
#undef PG8_SA
#undef PG8_SB
#undef PG8_STAGE
#undef PG8_LDA
#undef PG8_LDB
#undef PG8_MMA
#undef PG8_WAIT_V
#undef PG8_WAIT_L
#undef PG8_BAR
#undef PG8_SCHED
}
}

namespace att {
using pg8::bf16_t; using pg8::bf16x8;
typedef float f32x16 __attribute__((ext_vector_type(16)));
typedef float f32x4 __attribute__((ext_vector_type(4)));
typedef float f32v2 __attribute__((ext_vector_type(2)));
typedef __bf16 bf16v2 __attribute__((ext_vector_type(2)));
typedef unsigned u32x2 __attribute__((ext_vector_type(2)));
typedef unsigned u32x4 __attribute__((ext_vector_type(4)));
#define MFMA32(a, b, c) __builtin_amdgcn_mfma_f32_32x32x16_bf16((a), (b), (c), 0, 0, 0)
#define NOPACK(x) asm volatile("" : "+v"(x))
constexpr int NT = LP / 32;
constexpr float SC2 = 0.125f * LOG2E_F;
constexpr float NEGB = -1e30f;

__device__ __forceinline__ int chunk_of(int p) { return p < NMETA ? 0 : 1 + ((p - NMETA) >> 6); }
__device__ __forceinline__ unsigned pkbf(float lo, float hi) { f32v2 f = {lo, hi}; bf16v2 b = __builtin_convertvector(f, bf16v2); return __builtin_bit_cast(unsigned, b); }
__device__ __forceinline__ bf16x8 ld8(const bf16_t* p) { return *(const bf16x8*)p; }
template <int S> __device__ __forceinline__ bf16x8 pack8(const f32x16& p) {
    u32x4 w; w.x = pkbf(p[8 * S + 0], p[8 * S + 1]); w.y = pkbf(p[8 * S + 2], p[8 * S + 3]); w.z = pkbf(p[8 * S + 4], p[8 * S + 5]); w.w = pkbf(p[8 * S + 6], p[8 * S + 7]);
    return __builtin_bit_cast(bf16x8, w);
}
__device__ __forceinline__ int key_of_row(int i) { return 16 * (i >> 4) + 8 * ((i >> 2) & 1) + 4 * ((i >> 3) & 1) + (i & 3); }

#define ATTW_LAS __attribute__((address_space(3)))
struct WTile { bf16x8 g[8]; };
__device__ __forceinline__ void wtile_issue(WTile& w, const bf16_t* Kp, const bf16_t* VTp, int key0, int lane) {
#pragma unroll
    for (int i = 0; i < 4; ++i) { const int row = 8 * i + (lane >> 3), pos = lane & 7; w.g[i] = ld8(Kp + (size_t)(key0 + row) * QKLD + ((pos ^ ((row >> 1) & 7)) << 3)); }
#pragma unroll
    for (int i = 0; i < 4; ++i) { const int row = 16 * i + (lane >> 2), pos = lane & 3; w.g[4 + i] = ld8(VTp + (size_t)row * VTLD + key0 + ((pos ^ ((row >> 2) & 3)) << 3)); }
}
__device__ __forceinline__ void wtile_park(const WTile& w, ATTW_LAS unsigned char* W, int lane) {
#pragma unroll
    for (int i = 0; i < 4; ++i) *(ATTW_LAS bf16x8*)(W + (8 * i + (lane >> 3)) * 128 + (lane & 7) * 16) = w.g[i];
#pragma unroll
    for (int i = 0; i < 4; ++i) *(ATTW_LAS bf16x8*)(W + 4096 + (16 * i + (lane >> 2)) * 64 + (lane & 3) * 16) = w.g[4 + i];
}
__device__ __forceinline__ bf16x8 wtile_k(const ATTW_LAS unsigned char* W, int ko, int kk, int hi) { return *(const ATTW_LAS bf16x8*)(W + ko * 128 + (((2 * kk + hi) ^ ((ko >> 1) & 7)) << 4)); }
__device__ __forceinline__ bf16x8 wtile_v(const ATTW_LAS unsigned char* W, int r32, int dt, int ks, int hi) { return *(const ATTW_LAS bf16x8*)(W + 4096 + (32 * dt + r32) * 64 + (((2 * ks + hi) ^ ((r32 >> 2) & 3)) << 4)); }

template <int DV, int MODE>
__device__ __forceinline__ void flash_softmax(const bf16_t* Qp, const bf16_t* Kp, const bf16_t* VTp, int q0, float slope2, float m_init, float l_init,
                                              f32x16 (&o)[DV / 32], float& l_out, int lane, ATTW_LAS unsigned char* W) {
    static_assert(DV == 64, "wave-private staging is laid out for 64 value columns");
    const int r32 = lane & 31, hi = lane >> 5, t = q0 + r32, cq = chunk_of(t);
    bf16x8 qf[4];
#pragma unroll
    for (int kk = 0; kk < 4; ++kk) qf[kk] = ld8(Qp + (size_t)t * QKLD + 16 * kk + 8 * hi);
    const int ko = key_of_row(r32);
#pragma unroll
    for (int dt = 0; dt < DV / 32; ++dt)
#pragma unroll
        for (int r = 0; r < 16; ++r) o[dt][r] = 0.f;
    float m = m_init, l = l_init;
    const int cqmin = chunk_of(q0), cqmax = chunk_of(q0 + 31);
    const int endp = (NMETA + 64 * cqmax) < LP ? (NMETA + 64 * cqmax) : LP;
    const int kt_hi = (endp - 1) >> 5;
    int kt_lo = 0;
    if (MODE == 0) kt_lo = cqmin >= 3 ? ((NMETA + 64 * (cqmin - 3)) >> 5) : 0;
    const float nslope = -slope2;
    int it = (kt_lo > 0 ? kt_lo - 1 : 0);
    WTile w, w1;
    wtile_issue(w, Kp, VTp, (it < kt_lo ? 0 : it) * 32, lane);
    { const int i1 = it < kt_hi ? it + 1 : it; wtile_issue(w1, Kp, VTp, (i1 < kt_lo ? 0 : i1) * 32, lane); }
    for (; it <= kt_hi; ++it) {
        const int key0 = (it < kt_lo ? 0 : it) * 32;
        wtile_park(w, W, lane);
        w = w1;
        const int itn = it + 2 <= kt_hi ? it + 2 : kt_hi;
        wtile_issue(w1, Kp, VTp, (itn < kt_lo ? 0 : itn) * 32, lane);
        f32x16 s;
#pragma unroll
        for (int r = 0; r < 16; ++r) s[r] = 0.f;
#pragma unroll
        for (int kk = 0; kk < 4; ++kk) s = MFMA32(wtile_k(W, ko, kk, hi), qf[kk], s);
        const bool need_mask = (MODE == 0) ? !(key0 >= NMETA && chunk_of(key0 + 31) <= cqmin && chunk_of(key0) + 2 >= cqmax) : (chunk_of(key0 + 31) > cqmin);
        const float tf = (float)(t - key0 - 8 * hi);
        float mx = NEGB;
#pragma unroll
        for (int r = 0; r < 16; ++r) {
            const float dist = fabsf(tf - (float)(16 * (r >> 3) + (r & 7)));
            float v = fmaf(s[r], SC2, nslope * dist);
            if (need_mask) {
                const int kp = key0 + 16 * (r >> 3) + 8 * hi + (r & 7);
                const int ck = chunk_of(kp);
                const bool vis = (MODE == 0) ? ((kp < NMETA) || ((ck <= cq) && (ck + 2 >= cq))) : (ck <= cq);
                v = vis ? v : NEGB;
            }
            s[r] = v; mx = fmaxf(mx, v);
        }
        mx = fmaxf(mx, __shfl_xor(mx, 32));
        if (__any(mx > m + 32.0f)) {
            const float mnew = fmaxf(m, mx), alpha = __builtin_amdgcn_exp2f(m - mnew);
            m = mnew; l *= alpha;
#pragma unroll
            for (int dt = 0; dt < DV / 32; ++dt)
#pragma unroll
                for (int r = 0; r < 16; ++r) { float x = o[dt][r] * alpha; NOPACK(x); o[dt][r] = x; }
        }
        float ps = 0.f;
#pragma unroll
        for (int r = 0; r < 16; ++r) { const float p = __builtin_amdgcn_exp2f(s[r] - m); s[r] = p; ps += p; }
        l += ps;
        const bf16x8 p0 = pack8<0>(s), p1 = pack8<1>(s);
#pragma unroll
        for (int dt = 0; dt < DV / 32; ++dt) { o[dt] = MFMA32(wtile_v(W, r32, dt, 0, hi), p0, o[dt]); o[dt] = MFMA32(wtile_v(W, r32, dt, 1, hi), p1, o[dt]); }
    }
    l_out = l + __shfl_xor(l, 32);
}

#define ATT_LAS __attribute__((address_space(3)))
__device__ __forceinline__ bf16x8 lds8(const ATT_LAS unsigned char* p) { return *(const ATT_LAS bf16x8*)p; }
__device__ __forceinline__ void diff_flash(ATT_LAS unsigned char* L, const bf16_t* qk, const bf16_t* vt, int b, int head, int qb, int tid, int lane, int wave,
                                           float kmax2, ATT_LAS int* votes, f32x16 (&o)[4], float& l_out) {
    const int qsub = wave >> 1, comp = wave & 1, r32 = lane & 31, hi = lane >> 5;
    const size_t rowbase = (size_t)b * LPR;
    const int q0 = 128 * qb + 32 * qsub, t = q0 + r32, cq = chunk_of(t), cqmin = chunk_of(q0);
    const float nslope = -__builtin_amdgcn_exp2f(-0.5f * (float)(head + 1)) * LOG2E_F;
    bf16x8 qf[4];
    { const bf16_t* Qp = qk + (rowbase + t) * QKLD + head * 128 + comp * 64 + 8 * hi;
#pragma unroll
      for (int kk = 0; kk < 4; ++kk) qf[kk] = ld8(Qp + 16 * kk); }
    const int endw = (NMETA + 64 * chunk_of(q0 + 31)) < LP ? (NMETA + 64 * chunk_of(q0 + 31)) : LP, kt_hi = (endw - 1) >> 5;
    const int endb = (NMETA + 64 * chunk_of(128 * qb + 127)) < LP ? (NMETA + 64 * chunk_of(128 * qb + 127)) : LP, nst = (endb + 127) >> 7;
    const int lrow = tid >> 3, lpos = tid & 7, gch = lpos ^ ((lrow >> 1) & 7);
    const bf16_t* gK = qk + (rowbase + lrow) * QKLD + 2048 + head * 128 + gch * 8;
    const int vrow = tid >> 4, vpos = tid & 15, gcv = vpos ^ (vrow & 15);
    const bf16_t* gV = vt + (size_t)(head * 128 + vrow) * VTLD + rowbase + gcv * 8;
    const int wofs = tid * 16;
    const int ko = key_of_row(r32), jk = (ko >> 1) & 7, jv = (r32 >> 1) & 7;
    const int kbase = comp * 16384 + ko * 128, vbase = 32768 + r32 * 256, jv16 = r32 & 15;
#pragma unroll
    for (int dt = 0; dt < 4; ++dt)
#pragma unroll
        for (int r = 0; r < 16; ++r) o[dt][r] = 0.f;
    float m = NEGB, l = 0.f;
    float q2 = 0.f;
#pragma unroll
    for (int kk = 0; kk < 4; ++kk)
#pragma unroll
        for (int e = 0; e < 8; ++e) { const float f = __uint_as_float((unsigned)(unsigned short)qf[kk][e] << 16); q2 += f * f; }
    q2 += __shfl_xor(q2, 32);
    const float bq = sqrtf(q2 * kmax2) * SC2 * 1.001f + 0.01f;
    if (tid < 3) votes[tid] = 0;
    float pre[16];
#pragma unroll
    for (int r = 0; r < 16; ++r) pre[r] = -nslope * (float)(16 * (r >> 3) + (r & 7));
    bf16x8 g[8];
#define DF_LOAD(st) do { const size_t k0_ = (size_t)(st) * 128; g[0] = ld8(gK + k0_ * QKLD); g[1] = ld8(gK + (k0_ + 64) * QKLD); g[2] = ld8(gK + k0_ * QKLD + 64); g[3] = ld8(gK + (k0_ + 64) * QKLD + 64); \
        g[4] = ld8(gV + k0_); g[5] = ld8(gV + (size_t)32 * VTLD + k0_); g[6] = ld8(gV + (size_t)64 * VTLD + k0_); g[7] = ld8(gV + (size_t)96 * VTLD + k0_); } while (0)
#define DF_PARK(st) do { ATT_LAS unsigned char* W_ = L + ((st) & 1) * 65536 + wofs; *(ATT_LAS bf16x8*)(W_) = g[0]; *(ATT_LAS bf16x8*)(W_ + 8192) = g[1]; *(ATT_LAS bf16x8*)(W_ + 16384) = g[2]; *(ATT_LAS bf16x8*)(W_ + 24576) = g[3]; \
        *(ATT_LAS bf16x8*)(W_ + 32768) = g[4]; *(ATT_LAS bf16x8*)(W_ + 40960) = g[5]; *(ATT_LAS bf16x8*)(W_ + 49152) = g[6]; *(ATT_LAS bf16x8*)(W_ + 57344) = g[7]; } while (0)
    DF_LOAD(nst - 1);
    DF_PARK(nst - 1);
    __builtin_amdgcn_s_waitcnt(0);
    __syncthreads();
    for (int s = nst - 1, it = 0; s >= 0; --s, ++it) {
        const bool more = s > 0;
        if (more) DF_LOAD(s - 1);
        const ATT_LAS unsigned char* B = L + (s & 1) * 65536;
#pragma unroll
        for (int sb = 0; sb < 4; ++sb) {
            const int sub = 3 - sb, kt = 4 * s + sub, key0 = kt * 32;
            if (kt <= kt_hi) {
                f32x16 sc;
#pragma unroll
                for (int r = 0; r < 16; ++r) sc[r] = 0.f;
#pragma unroll
                for (int kk = 0; kk < 4; ++kk) { const bf16x8 kf = lds8(B + kbase + sub * 4096 + (((2 * kk + hi) ^ jk) << 4)); sc = MFMA32(kf, qf[kk], sc); }
                const bool far = key0 + 31 <= q0;
                float mx = NEGB, base;
                if (far) {
                    base = -nslope * (float)(key0 + 8 * hi);
#pragma unroll
                    for (int r = 0; r < 16; ++r) { float v = fmaf(sc[r], SC2, pre[r]); NOPACK(v); sc[r] = v; mx = fmaxf(mx, v); }
                } else {
                    const bool need_mask = chunk_of(key0 + 31) > cqmin;
                    const float tf = (float)(t - key0 - 8 * hi);
                    base = -nslope * (float)t;
#pragma unroll
                    for (int r = 0; r < 16; ++r) {
                        const float dist = fabsf(tf - (float)(16 * (r >> 3) + (r & 7)));
                        float v = fmaf(sc[r], SC2, nslope * dist);
                        if (need_mask) { const int kp = key0 + 16 * (r >> 3) + 8 * hi + (r & 7); v = (chunk_of(kp) <= cq) ? v : NEGB; }
                        sc[r] = v; mx = fmaxf(mx, v);
                    }
                }
                mx += base;
                mx = fmaxf(mx, __shfl_xor(mx, 32));
                if (__any(mx > m + 32.0f)) {
                    const float mnew = fmaxf(m, mx), alpha = __builtin_amdgcn_exp2f(m - mnew);
                    m = mnew; l *= alpha;
#pragma unroll
                    for (int dt = 0; dt < 4; ++dt)
#pragma unroll
                        for (int r = 0; r < 16; ++r) { float x = o[dt][r] * alpha; NOPACK(x); o[dt][r] = x; }
                }
                const float mb = m - base;
                float ps = 0.f;
#pragma unroll
                for (int r = 0; r < 16; ++r) { const float p = __builtin_amdgcn_exp2f(sc[r] - mb); sc[r] = p; ps += p; }
                l += ps;
                const bf16x8 p0 = pack8<0>(sc), p1 = pack8<1>(sc);
#pragma unroll
                for (int dt = 0; dt < 4; ++dt) {
                    const bf16x8 v0 = lds8(B + vbase + dt * 8192 + (((sub * 4 + hi) ^ jv16) << 4)), v1 = lds8(B + vbase + dt * 8192 + (((sub * 4 + 2 + hi) ^ jv16) << 4));
                    o[dt] = MFMA32(v0, p0, o[dt]); o[dt] = MFMA32(v1, p1, o[dt]); }
            }
        }
        if (more) DF_PARK(s - 1);
        const bool quit = more && __all((bq - nslope * (float)(128 * s - 1)) - m < -64.0f);
        if (lane == 0 && quit) __hip_atomic_fetch_add(votes + it % 3, 1, __ATOMIC_RELAXED, __HIP_MEMORY_SCOPE_WORKGROUP);
        if (tid == 0) votes[(it + 1) % 3] = 0;
        __syncthreads();
        if (votes[it % 3] == 8) break;
    }
    l_out = l + __shfl_xor(l, 32);
}

#undef DF_LOAD
#undef DF_PARK
__device__ __forceinline__ void flash_stick(const bf16_t* Qp, const bf16_t* Kp, const bf16_t* VTp, int qt, f32x16 (&o)[2], int lane, ATTW_LAS unsigned char* W) {
    const int r32 = lane & 31, hi = lane >> 5, t = 32 * qt + r32;
    bf16x8 qf[4];
#pragma unroll
    for (int kk = 0; kk < 4; ++kk) qf[kk] = ld8(Qp + (size_t)t * QKLD + 16 * kk + 8 * hi);
    const int ko = key_of_row(r32);
#pragma unroll
    for (int dt = 0; dt < 2; ++dt)
#pragma unroll
        for (int r = 0; r < 16; ++r) o[dt][r] = 0.f;
    float R = 0.f;
    WTile w, w1;
    wtile_issue(w, Kp, VTp, qt * 32, lane);
    wtile_issue(w1, Kp, VTp, (qt > 0 ? qt - 1 : 0) * 32, lane);
    for (int kt = qt; kt >= 0; --kt) {
        const int key0 = kt * 32;
        wtile_park(w, W, lane);
        w = w1;
        wtile_issue(w1, Kp, VTp, (kt > 1 ? kt - 2 : 0) * 32, lane);
        f32x16 s;
#pragma unroll
        for (int r = 0; r < 16; ++r) s[r] = 0.f;
#pragma unroll
        for (int kk = 0; kk < 4; ++kk) s = MFMA32(wtile_k(W, ko, kk, hi), qf[kk], s);
        const bool diag = (kt == qt);
        f32x16 lk;
#pragma unroll
        for (int r = 0; r < 16; ++r) {
            const float z = s[r] * SC2, L = __builtin_amdgcn_logf(1.0f + __builtin_amdgcn_exp2f(-fabsf(z)));
            float lsv = fminf(z, 0.f) - L, lkv = fminf(-z, 0.f) - L;
            if (diag) { const int kp = key0 + 16 * (r >> 3) + 8 * hi + (r & 7); const bool strict = kp < t; lsv = strict ? lsv : NEGB; lkv = strict ? lkv : 0.f; }
            s[r] = lsv; lk[r] = lkv;
        }
        f32x16 bt;
        float ta = 0.f, tb = 0.f;
#pragma unroll
        for (int j = 7; j >= 0; --j) { bt[j] = ta; ta += lk[j]; bt[8 + j] = tb; tb += lk[8 + j]; }
        const float pa = __shfl_xor(ta, 32), pb = __shfl_xor(tb, 32);
        const float offB = R + (hi ? 0.f : pb), offA = R + tb + pb + (hi ? 0.f : pa);
#pragma unroll
        for (int j = 0; j < 8; ++j) { s[j] = __builtin_amdgcn_exp2f(s[j] + bt[j] + offA); s[8 + j] = __builtin_amdgcn_exp2f(s[8 + j] + bt[8 + j] + offB); }
        const bf16x8 p0 = pack8<0>(s), p1 = pack8<1>(s);
#pragma unroll
        for (int dt = 0; dt < 2; ++dt) { o[dt] = MFMA32(wtile_v(W, r32, dt, 0, hi), p0, o[dt]); o[dt] = MFMA32(wtile_v(W, r32, dt, 1, hi), p1, o[dt]); }
        R += (ta + tb) + (pa + pb);
        if (__all(R < -64.0f)) break;
    }
}

__device__ __forceinline__ void store_pair16(bf16_t* rowp  , u32x2 a  , u32x2 b  , int hi) {
    typedef unsigned u32v2 __attribute__((ext_vector_type(2)));
    const u32v2 rx = __builtin_amdgcn_permlane32_swap(a.x, b.x, false, false), ry = __builtin_amdgcn_permlane32_swap(a.y, b.y, false, false);
    u32x4 w; w.x = rx[0]; w.y = ry[0]; w.z = rx[1]; w.w = ry[1];
    *(u32x4*)(rowp + 8 * hi) = w;
}
template <int DV>
__device__ __forceinline__ void store_o(const f32x16 (&o)[DV / 32], float scale, bf16_t* dst  , int lane) {
    const int hi = lane >> 5;
#pragma unroll
    for (int dt = 0; dt < DV / 32; ++dt)
#pragma unroll
        for (int gp = 0; gp < 4; gp += 2) {
            u32x2 a, b;
            a.x = pkbf(o[dt][4 * gp] * scale, o[dt][4 * gp + 1] * scale); a.y = pkbf(o[dt][4 * gp + 2] * scale, o[dt][4 * gp + 3] * scale);
            b.x = pkbf(o[dt][4 * gp + 4] * scale, o[dt][4 * gp + 5] * scale); b.y = pkbf(o[dt][4 * gp + 6] * scale, o[dt][4 * gp + 7] * scale);
            store_pair16(dst + 32 * dt + 8 * gp, a, b, hi); }
}
}

#define LAS __attribute__((address_space(3)))
typedef unsigned short bf16;
typedef unsigned v4u __attribute__((ext_vector_type(4)));
typedef float f32x4 __attribute__((ext_vector_type(4)));
constexpr int NWAVES = 8;
constexpr int LDS_BYTES = 147456;
constexpr int LDS_MISC = 131072;
constexpr size_t MiB = 1u << 20;
constexpr size_t WS_CTL = 0;
constexpr size_t WS_SS = 4096, SS_STRIDE = (size_t)MROWS * 4, WS_BAR = 262144;
constexpr size_t WS_WIN0 = 1 * MiB, WS_WOUT0 = 19 * MiB, WS_WMI0 = 27 * MiB, WS_WMO0 = 59 * MiB, WS_WIN1 = 91 * MiB, WS_WOUT1 = 115 * MiB, WS_WMI1 = 123 * MiB, WS_WMO1 = 155 * MiB;
constexpr size_t WS_H = 187 * MiB, WS_XA = 255 * MiB, WS_X = 289 * MiB, WS_QK = WS_X, WS_VT = WS_X + 68 * MiB, WS_ATT = WS_X + 102 * MiB, WS_U = WS_X, WS_PART = 425 * MiB, WS_END = 489 * MiB;
static_assert((size_t)MROWS * DM * 4 == 68 * MiB && (size_t)MROWS * DM * 2 == 34 * MiB && (size_t)MROWS * QKLD * 2 == 68 * MiB && (size_t)MROWS * DFF * 2 == 136 * MiB, "ws map");

__device__ __forceinline__ unsigned f2bf(float f) { unsigned u = __builtin_bit_cast(unsigned, f); return (u + 0x7fffu + ((u >> 16) & 1u)) >> 16; }
__device__ __forceinline__ unsigned pk2(float lo, float hi) { return f2bf(lo) | (f2bf(hi) << 16); }
__device__ __forceinline__ float wave_sum(float v) {
#pragma unroll
    for (int o = 1; o < 64; o <<= 1) v += __shfl_xor(v, o);
    return v;
}
__device__ __forceinline__ void p0_transpose_item(const float* W, int K, int N, bf16* WT, int remap, const float* gain, LAS float* scr, int item, int lane) {
    const int nblk = N / 32, kb = item / nblk, nb = item % nblk, k0 = 64 * kb, n0 = 32 * nb;
    int row_off = 0;
    if (remap) { if (n0 >= 1280 && n0 < 1536) row_off = 2048; else if (n0 >= 1536 && n0 < 3584) row_off = -256; }
    { const int row8 = lane >> 3, c4 = lane & 7;
      f32x4 v[8];
#pragma unroll
      for (int i = 0; i < 8; ++i) v[i] = __builtin_nontemporal_load((const f32x4*)(W + (size_t)(k0 + 8 * i + row8) * N + n0 + 4 * c4));
      if (gain) {
#pragma unroll
        for (int i = 0; i < 8; ++i) v[i] = v[i] * gain[k0 + 8 * i + row8]; }
#pragma unroll
      for (int i = 0; i < 8; ++i) { LAS float* d = scr + (8 * i + row8) * 33 + 4 * c4; d[0] = v[i].x; d[1] = v[i].y; d[2] = v[i].z; d[3] = v[i].w; } }
    asm volatile("s_waitcnt lgkmcnt(0)" ::: "memory");
    const int c = lane & 7;
#pragma unroll
    for (int j = 0; j < 4; ++j) { const int n = (lane >> 3) + 8 * j; const LAS float* s = scr + (8 * c) * 33 + n;
        v4u o; o.x = pk2(s[0 * 33], s[1 * 33]); o.y = pk2(s[2 * 33], s[3 * 33]); o.z = pk2(s[4 * 33], s[5 * 33]); o.w = pk2(s[6 * 33], s[7 * 33]);
        __builtin_nontemporal_store(o, (v4u*)(WT + (size_t)(row_off + n0 + n) * K + k0 + 8 * c)); }
    asm volatile("s_waitcnt lgkmcnt(0)" ::: "memory");
}

#ifndef REP_ATT0
#define REP_ATT0 1
#endif
#ifndef REP_ATT1
#define REP_ATT1 1
#endif
#ifndef REP_P0
#define REP_P0 1
#endif
#define XB_TMO      128
#define XB_XCNT(j)  (256  + 64 * (j))
#define XB_XSUB(j)  (1280 + 64 * (j))
#define XB_XGEN(j)  (2304 + 64 * (j))
#define XB_TOP      3328
#define XB_TOPGEN   3392
#define XCD_BAR_WORDS 3456
#define XB_SPIN_CAP (1u << 18)

__device__ __forceinline__ unsigned xb_ld(unsigned* p)              { return __hip_atomic_load(p, __ATOMIC_RELAXED, __HIP_MEMORY_SCOPE_AGENT); }
__device__ __forceinline__ unsigned xb_add(unsigned* p, unsigned v) { return __hip_atomic_fetch_add(p, v, __ATOMIC_RELAXED, __HIP_MEMORY_SCOPE_AGENT); }
__device__ __forceinline__ unsigned xb_xcc_id() { return (unsigned)__builtin_amdgcn_s_getreg((3 << 11) | 20) & 0xFu; }
#define XB_SPIN(cond, bar) do { unsigned _sp = 0; while (cond) { __builtin_amdgcn_s_sleep(1); \
    if ((++_sp & 255u) == 0u) { if (xb_ld(&(bar)[XB_TMO])) break; if (_sp > XB_SPIN_CAP) { atomicAdd(&(bar)[XB_TMO], 1u); break; } } } } while (0)

struct XcdBarrier {
    unsigned* bar; unsigned x;
    volatile LAS unsigned* st;
};

__device__ __forceinline__ XcdBarrier xcd_barrier_post(unsigned* bar, volatile LAS unsigned* st) {
    XcdBarrier b; b.bar = bar; b.x = xb_xcc_id(); b.st = st;
    if (threadIdx.x == 0) (void)xb_add(&bar[XB_XCNT(b.x)], 1u);
    return b;
}
__device__ __forceinline__ void xcd_barrier_complete(unsigned* bar, unsigned x, unsigned& nloc, unsigned& nx) {
    const unsigned G = gridDim.x * gridDim.y * gridDim.z;
    unsigned sum, cnt, mine, sp = 0u;
    for (;;) {
        sum = 0u; cnt = 0u; mine = 0u;
#pragma unroll
        for (unsigned j = 0; j < 16; ++j) { const unsigned c = xb_ld(&bar[XB_XCNT(j)]); sum += c; cnt += (c > 0u) ? 1u : 0u; mine = (j == x) ? c : mine; }
        if (sum == G) break;
        __builtin_amdgcn_s_sleep(1);
        if ((++sp & 255u) == 0u) { if (xb_ld(&bar[XB_TMO])) break; if (sp > XB_SPIN_CAP) { atomicAdd(&bar[XB_TMO], 1u); break; } }
    }
    nloc = mine > 0u ? mine : 1u; nx = cnt > 0u ? cnt : 1u;
}

__device__ __forceinline__ void xcd_barrier(const XcdBarrier& b) {
    asm volatile("s_waitcnt vmcnt(0)" ::: "memory");
    __syncthreads();
    if (threadIdx.x == 0) {
        unsigned* bar = b.bar;
        __builtin_amdgcn_s_waitcnt(0);
        unsigned nloc = b.st[0], nx = b.st[1];
        if (nloc == 0u) { xcd_barrier_complete(bar, b.x, nloc, nx); b.st[0] = nloc; b.st[1] = nx; }
        const unsigned old = xb_add(&bar[XB_XSUB(b.x)], 1u);
        const unsigned gen = old / nloc;
        if (old + 1u == (gen + 1u) * nloc) {
            __builtin_amdgcn_fence(__ATOMIC_RELEASE, "agent");
            asm volatile("s_waitcnt vmcnt(0)" ::: "memory");
            const unsigned og = xb_add(&bar[XB_TOP], 1u);
            const unsigned tg = og / nx;
            if (og + 1u == (tg + 1u) * nx) xb_add(&bar[XB_TOPGEN], 1u);
            else XB_SPIN(xb_ld(&bar[XB_TOPGEN]) == tg, bar);
            __builtin_amdgcn_fence(__ATOMIC_ACQUIRE, "agent");
            xb_add(&bar[XB_XGEN(b.x)], 1u);
            asm volatile("s_waitcnt vmcnt(0)" ::: "memory");
        } else {
            XB_SPIN(xb_ld(&bar[XB_XGEN(b.x)]) == gen, bar);
            __builtin_amdgcn_fence(__ATOMIC_ACQUIRE, "agent");
            asm volatile("s_waitcnt vmcnt(0)" ::: "memory");
        }
    }
    __syncthreads();
}

__device__ __forceinline__ void pull_convert(int* ctr, const float* W0, int K0, int N0, bf16* T0, int n0, const float* G0, const float* W1, int K1, int N1, bf16* T1, int n1, const float* G1, LAS float* scr, LAS int* slot, int tid, int wave, int lane) {
    asm volatile("" : "+v"(lane));
    for (;;) {
        __syncthreads();
        if (tid == 0) *slot = atomicAdd(ctr, 32);
        __syncthreads();
        const int base = *slot;
        if (base >= n0 + n1) break;
#pragma unroll 1
        for (int j = 0; j < 4; ++j) { const int it = base + wave * 4 + j;
            if (it < n0) p0_transpose_item(W0, K0, N0, T0, 0, G0, scr, it, lane); else if (it < n0 + n1) p0_transpose_item(W1, K1, N1, T1, 0, G1, scr, it - n0, lane); }
    }
}
template <int S>
__device__ __forceinline__ void tail_fixup(bf16* hb, float* ss, float* ssc, const float* part, int gw, int NGW, int lane) {
    asm volatile("" : "+v"(lane));
    for (int r = gw * 64 + lane; r < 8192; r += NGW * 64) ssc[r] = pg8::row_ss(ss, r);
    for (int task = gw; task < 256 * 8; task += NGW) {
        const int rr = task >> 3, pn = task & 7, row = 8192 + rr, tile = pn, r = rr, c = pn * 256 + lane * 4;
        const unsigned long long o = *(const unsigned long long*)(hb + (size_t)row * DM + c);
        f32x4 v = {__uint_as_float((unsigned)o << 16), __uint_as_float((unsigned)o & 0xffff0000u), __uint_as_float((unsigned)(o >> 32) << 16), __uint_as_float((unsigned)(o >> 32) & 0xffff0000u)};
        const float* pp = part + ((size_t)(tile * S) << 16) + (size_t)r * 256 + lane * 4;
#pragma unroll
        for (int p = 0; p < S; ++p) v += __builtin_nontemporal_load((const f32x4*)(pp + ((size_t)p << 16)));
        float s = (v.x * v.x + v.y * v.y) + (v.z * v.z + v.w * v.w);
        *(unsigned long long*)(hb + (size_t)row * DM + c) = (unsigned long long)pk2(v.x, v.y) | ((unsigned long long)pk2(v.z, v.w) << 32);
        s = wave_sum(s);
        if (lane == 0) *(f32x4*)(ss + (size_t)row * 32 + pn * 4) = (f32x4){s, 0.f, 0.f, 0.f};
    }
}
struct Args { const float* in[15]; float* out; unsigned char* ws; int ph_lo, ph_hi; };
constexpr int NPHASE = 12;

__global__ void __launch_bounds__(NWAVES * 64, 2) fwd_kernel(Args a) {
    extern __shared__ __attribute__((aligned(16))) unsigned char lds[];
    cg::grid_group grid = cg::this_grid();
    LAS unsigned char* L = (LAS unsigned char*)lds;
    const int tid = threadIdx.x, lane = tid & 63, wave = __builtin_amdgcn_readfirstlane(tid >> 6);
    const int G = gridDim.x, bx = blockIdx.x;
    unsigned char* ws = a.ws;
    int* ctr = (int*)(ws + WS_CTL);
    float* kmaxw = (float*)(ws + WS_CTL + 2048);
    float* ssc0 = (float*)(ws + WS_SS);
    float* ss0 = (float*)(ws + WS_XA);
    float* ss1 = ss0 + (size_t)MROWS * 32; float* ss2 = ss1 + (size_t)MROWS * 32; float* ss3 = ss2 + (size_t)MROWS * 32; float* ss4 = ss3 + (size_t)MROWS * 32;
    bf16* win0 = (bf16*)(ws + WS_WIN0); bf16* wout0 = (bf16*)(ws + WS_WOUT0); bf16* wmi0 = (bf16*)(ws + WS_WMI0); bf16* wmo0 = (bf16*)(ws + WS_WMO0);
    bf16* win1 = (bf16*)(ws + WS_WIN1); bf16* wout1 = (bf16*)(ws + WS_WOUT1); bf16* wmi1 = (bf16*)(ws + WS_WMI1); bf16* wmo1 = (bf16*)(ws + WS_WMO1);
    bf16* hb = (bf16*)(ws + WS_H);
     bf16* qk = (bf16*)(ws + WS_QK); bf16* vt = (bf16*)(ws + WS_VT); bf16* attb = (bf16*)(ws + WS_ATT); bf16* ub = (bf16*)(ws + WS_U); float* part = (float*)(ws + WS_PART);
    const int lo = a.ph_lo, hi_ph = a.ph_hi;
    constexpr int I_IN0 = (DM / 64) * (4608 / 32), I_OUT = (DM / 64) * (DM / 32), I_MI = (DM / 64) * (DFF / 32), I_MO = (DFF / 64) * (DM / 32), I_IN1 = (DM / 64) * (6144 / 32);
    LAS float* cscr = (LAS float*)(L + wave * 16384);
    volatile LAS unsigned* xst = (volatile LAS unsigned*)(L + LDS_MISC + 64);
    if (tid < 2) xst[tid] = 0u;
    __syncthreads();
    unsigned* barw = (unsigned*)(ws + WS_BAR);
    XcdBarrier xbar; xbar.bar = barw; xbar.x = 0; xbar.st = xst;
#define IN(k) (lo <= (k) && (k) < hi_ph)
#define SEAM(k) do { if (IN(k) && IN((k) + 1)) xcd_barrier(xbar); } while (0)

    if (IN(0)) for (int rep0 = 0; rep0 < REP_P0; ++rep0) {
        LAS float* scr = (LAS float*)(L + wave * 16384);
        const int gw = bx * NWAVES + wave, NGW = G * NWAVES;
        for (int it = gw; it < I_IN0; it += NGW) p0_transpose_item(a.in[3], DM, 4608, win0, 1, a.in[2], scr, it, lane);
        for (int m = gw; m < MR; m += NGW) {
            const int b = m / LPR, t = m % LPR;
            const float* src = m >= RVALID ? nullptr : (t < NMETA ? a.in[1] + (size_t)t * DM : a.in[0] + ((size_t)b * SEQ + (t - NMETA)) * DM);
            float s = 0.f;
#pragma unroll
            for (int j = 0; j < 8; ++j) {
                const int c = (64 * j + lane) * 4;
                f32x4 v = src ? __builtin_nontemporal_load((const f32x4*)(src + c)) : (f32x4){0.f, 0.f, 0.f, 0.f};
                s += (v.x * v.x + v.y * v.y) + (v.z * v.z + v.w * v.w);
                *(unsigned long long*)(hb + (size_t)m * DM + c) = (unsigned long long)pk2(v.x, v.y) | ((unsigned long long)pk2(v.z, v.w) << 32);
            }
            s = wave_sum(s);
            if (lane < 32) ss0[(size_t)m * 32 + lane] = lane == 0 ? s : 0.f;
            if (lane == 0) ssc0[m] = s;
        }
        if (bx == 0 && tid < 64) { ctr[tid] = 0; kmaxw[tid] = 0.f; }
        if (bx == 0) for (int i = tid; i < XCD_BAR_WORDS; i += NWAVES * 64) barw[i] = 0u;
    }
    grid.sync();
    xbar = xcd_barrier_post(barw, xst);

#pragma unroll 1
    for (int layer = 0; layer < 2; ++layer) {
        const int pb = 1 + 5 * layer;
        const float* ss_in = layer == 0 ? ss0 : ss2; float* ss_mid = layer == 0 ? ss1 : ss3; float* ss_out = layer == 0 ? ss2 : ss4;
        const float* ssc_in = ssc0 + (layer == 0 ? 0 : 2) * MROWS; float* ssc_mid = ssc0 + (layer == 0 ? 1 : 3) * MROWS; float* ssc_out = ssc0 + (layer == 0 ? 2 : 4) * MROWS;
        const bf16* w_in = layer == 0 ? win0 : win1; const bf16* w_out = layer == 0 ? wout0 : wout1; const bf16* w_mi = layer == 0 ? wmi0 : wmi1; const bf16* w_mo = layer == 0 ? wmo0 : wmo1;
        const int nqk = layer == 0 ? 3328 : 4096, nv = layer == 0 ? 1280 : 2048;
        if (IN(pb)) {
            pg8::Gemm g{hb, w_in, w_in + (size_t)nqk * DM, hb, DM};
            pg8::DualOrder S; S.init(MR, nqk, nv, MR, DM, G, bx);
            pg8::EpiProj E{qk, QKLD, vt, VTLD, ss_in, ssc_in, layer == 1 ? kmaxw : nullptr, 2048, 4096};
            pg8::gemm_phase<pg8::EpiProj, pg8::DualOrder, true, true>(L, g, S, E);
            if (layer == 0) pull_convert(ctr + 8, a.in[5], DM, DM, wout0, I_OUT, nullptr, a.in[12], DM, DFF, wmi0, I_MI, a.in[11], cscr, (LAS int*)(L + LDS_MISC), tid, wave, lane);
            else pull_convert(ctr + 9, a.in[12] + (size_t)DM * DFF, DM, DFF, wmi1, I_MI, a.in[11] + DM, a.in[10], DM, DM, wout1, I_OUT, nullptr, cscr, (LAS int*)(L + LDS_MISC), tid, wave, lane);
        }
        SEAM(pb);
        if (IN(pb + 1)) for (int rep = 0; rep < (layer == 0 ? REP_ATT0 : REP_ATT1); ++rep) {
            { int t_ = tid; asm volatile("" : "+v"(t_));
              for (int i = bx * 512 + t_; i < (MR - RVALID) * DM / 8; i += G * 512) *(v4u*)(attb + (size_t)RVALID * DM + (size_t)i * 8) = (v4u){0u, 0u, 0u, 0u}; }
            LAS int* s_unit = (LAS int*)(L + LDS_MISC);
            int* q = ctr + layer + 2 * rep;
            if (layer == 0) {
                constexpr int NB = NBATCH * NQT * 2, NA = NB;
                for (;;) {
                    __syncthreads();
                    if (tid == 0) *s_unit = atomicAdd(q, 1);
                    __syncthreads();
                    int u = *s_unit;
                    if (u >= NB + NA) break;
                    int lane = tid & 63; asm volatile("" : "+v"(lane));
                    const bool isB = u < NB; if (!isB) u -= NB;
                    const int qt = NQT - 1 - (u >> 3), rem = u & 7, b = rem >> 1, head = (rem & 1) * 8 + wave;
                    const size_t rowbase = (size_t)b * LPR;
                    const int r32 = lane & 31;
                    const bool real = 32 * qt + r32 < LPR;
                    if (isB) {
                        att::f32x16 o[2];
                        att::flash_stick(qk + rowbase * QKLD + 1280 + head * 64, qk + rowbase * QKLD + 2304 + head * 64, vt + (size_t)(256 + head * 64) * VTLD + rowbase, qt, o, lane, L + wave * 16384);
                        if (real) att::store_o<64>(o, 1.0f, attb + (rowbase + 32 * qt + r32) * DM + 1024 + head * 64, lane);
                    } else {
                        att::f32x16 o[2]; float l;
                        const float slope2 = __builtin_amdgcn_exp2f(-0.5f * (float)(head + 1)) * LOG2E_F, sink2 = a.in[4][head] * LOG2E_F;
                        att::flash_softmax<64, 0>(qk + rowbase * QKLD + head * 64, qk + rowbase * QKLD + 1024 + (head >> 2) * 64, vt + (size_t)((head >> 2) * 64) * VTLD + rowbase, 32 * qt, slope2,
                                                  sink2, (lane >> 5) ? 0.f : 1.f, o, l, lane, L + wave * 16384);
                        if (real) att::store_o<64>(o, 1.0f / l, attb + (rowbase + 32 * qt + r32) * DM + head * 64, lane);
                    }
                }
            } else {
                constexpr int NC = NBATCH * att::NT * 4;
                const float* lv = a.in[8];
                int ln = tid & 63; asm volatile("" : "+v"(ln));
                const float d1 = wave_sum(lv[ln] * lv[64 + ln]), d2 = wave_sum(lv[128 + ln] * lv[192 + ln]);
                const float lambda_init = 0.8f - 0.6f * expf(-0.3f);
                const float lam = expf(d1) - expf(d2) + lambda_init;
                const float* subg = a.in[9];
                for (;;) {
                    __syncthreads();
                    if (tid == 0) *s_unit = atomicAdd(q, 1);
                    __syncthreads();
                    const int u = *s_unit;
                    if (u >= NC) break;
                    int lane = tid & 63; asm volatile("" : "+v"(lane));
                    const int qb = 16 - (u >> 6), rem = u & 63, b = rem >> 4, head = rem & 15, qt = 4 * qb + (wave >> 1), comp = wave & 1;
                    const size_t rowbase = (size_t)b * LPR;
                    const int r32 = lane & 31, hi = lane >> 5;
                    att::f32x16 o[4]; float l;
                    const float kmax2 = kmaxw[4 * head + 2 * (wave & 1)] + kmaxw[4 * head + 2 * (wave & 1) + 1];
                    att::diff_flash(L, qk, vt, b, head, qb, tid, lane, wave, kmax2, (ATT_LAS int*)(L + LDS_MISC + 128), o, l);
                    const float inv = 1.0f / l;
                    LAS float* xch = (LAS float*)(L + (wave >> 1) * 16384);
                    if (comp == 1) {
#pragma unroll
                        for (int dt = 0; dt < 4; ++dt)
#pragma unroll
                            for (int r = 0; r < 16; ++r) xch[(dt * 16 + r) * 64 + lane] = o[dt][r] * inv;
                    }
                    __syncthreads();
                    if (comp == 0 && 32 * qt + r32 < LPR) {
                        float sq = 0.f;
#pragma unroll
                        for (int dt = 0; dt < 4; ++dt)
#pragma unroll
                            for (int r = 0; r < 16; ++r) { const float v = o[dt][r] * inv - lam * xch[(dt * 16 + r) * 64 + lane]; o[dt][r] = v; sq += v * v; }
                        sq += __shfl_xor(sq, 32);
                        const float rn = rsqrtf(sq * (1.0f / 128.0f) + RMS_EPS) * (1.0f - lambda_init);
                        bf16* dst = attb + (rowbase + 32 * qt + r32) * DM + head * 128;
#pragma unroll
                        for (int dt = 0; dt < 4; ++dt)
#pragma unroll
                            for (int gp = 0; gp < 4; gp += 2) { const int d = 32 * dt + 8 * gp + 4 * hi; const f32x4 ga = *(const f32x4*)(subg + d), gb = *(const f32x4*)(subg + d + 8);
                                att::u32x2 wa, wb; wa.x = att::pkbf(o[dt][4 * gp] * rn * ga.x, o[dt][4 * gp + 1] * rn * ga.y); wa.y = att::pkbf(o[dt][4 * gp + 2] * rn * ga.z, o[dt][4 * gp + 3] * rn * ga.w);
                                wb.x = att::pkbf(o[dt][4 * gp + 4] * rn * gb.x, o[dt][4 * gp + 5] * rn * gb.y); wb.y = att::pkbf(o[dt][4 * gp + 6] * rn * gb.z, o[dt][4 * gp + 7] * rn * gb.w);
                                att::store_pair16(dst + 32 * dt + 8 * gp, wa, wb, hi); }
                    }
                }
            }
        }
        SEAM(pb + 1);
        if (IN(pb + 2)) {
            pg8::Gemm g{attb, w_out, attb, w_out, DM};
            pg8::TailSplitOrder<2> S; S.init(DM, G, bx);
            pg8::EpiResid<2> E{hb, ss_mid, part};
            pg8::gemm_phase<pg8::EpiResid<2>, pg8::TailSplitOrder<2>, true, true>(L, g, S, E);
            xcd_barrier(xbar);
            tail_fixup<4>(hb, ss_mid, ssc_mid, part, bx * NWAVES + wave, G * NWAVES, lane);
        }
        SEAM(pb + 2);
        if (IN(pb + 3)) {
            pg8::Gemm g{hb, w_mi, hb, w_mi, DM};
            pg8::DualOrder S; S.init(MR, DFF, 0, 0, DM, G, bx);
            pg8::EpiMlpUp E{ub, DFF, ss_mid, ssc_mid};
            pg8::gemm_phase<pg8::EpiMlpUp, pg8::DualOrder, true, true>(L, g, S, E);
            if (layer == 0) pull_convert(ctr + 12, a.in[13], DFF, DM, wmo0, I_MO, nullptr, a.in[7], DM, 6144, win1, I_IN1, a.in[6], cscr, (LAS int*)(L + LDS_MISC), tid, wave, lane);
            else pull_convert(ctr + 11, a.in[13] + (size_t)DFF * DM, DFF, DM, wmo1, I_MO, nullptr, nullptr, 0, 32, nullptr, 0, nullptr, cscr, (LAS int*)(L + LDS_MISC), tid, wave, lane);
        }
        SEAM(pb + 3);
        if (IN(pb + 4)) {
            pg8::Gemm g{ub, w_mo, ub, w_mo, DFF};
            pg8::TailSplitOrder<3> S; S.init(DFF, G, bx);
            pg8::EpiResid<3> E{hb, ss_out, part};
            pg8::gemm_phase<pg8::EpiResid<3>, pg8::TailSplitOrder<3>, true, true>(L, g, S, E);
            xcd_barrier(xbar);
            tail_fixup<8>(hb, ss_out, ssc_out, part, bx * NWAVES + wave, G * NWAVES, lane);
        }
        SEAM(pb + 4);
    }

    if (IN(11)) {
        const int gw = bx * NWAVES + wave, NGW = G * NWAVES;
        const float* gf = a.in[14];
        for (int r = gw; r < NBATCH * SEQ; r += NGW) {
            const int b = r / SEQ, s = r % SEQ; const size_t m = (size_t)b * LPR + NMETA + s;
            const float rs = rsqrtf((m >= 8192 ? pg8::row_ss(ss4, (int)m) : ssc0[4 * MROWS + m]) * (1.0f / DM) + RMS_EPS);
#pragma unroll
            for (int j = 0; j < 8; ++j) { const int c = (64 * j + lane) * 4; const unsigned long long o = __builtin_nontemporal_load((const unsigned long long*)(hb + m * DM + c)); const f32x4 g = *(const f32x4*)(gf + c);
                const f32x4 v = {__uint_as_float((unsigned)o << 16), __uint_as_float((unsigned)o & 0xffff0000u), __uint_as_float((unsigned)(o >> 32) << 16), __uint_as_float((unsigned)(o >> 32) & 0xffff0000u)};
                __builtin_nontemporal_store(v * rs * g, (f32x4*)(a.out + (size_t)r * DM + c)); }
        }
    }
#undef IN
#undef SEAM
}

#ifndef MK_N_LAUNCHES
#define MK_N_LAUNCHES 1
#endif

extern "C" void kernel_launch(void* const* d_in, const int* in_sizes, int n_in, void* d_out, int out_size, void* d_ws, size_t ws_size, hipStream_t stream) {
    static int grid = 0;
    if (grid == 0) {
        if (n_in != 15 || out_size != NBATCH * SEQ * DM || ws_size < WS_END) { fprintf(stderr, "kernel_launch: unexpected shapes (n_in %d, out %d, ws %zu); nothing launched\n", n_in, out_size, ws_size); grid = -1; return; }
        int dev = 0, cus = 0, per_cu = 0;
        if (hipGetDevice(&dev) != hipSuccess || hipDeviceGetAttribute(&cus, hipDeviceAttributeMultiprocessorCount, dev) != hipSuccess) { grid = -1; return; }
        if (hipFuncSetAttribute((const void*)fwd_kernel, hipFuncAttributeMaxDynamicSharedMemorySize, LDS_BYTES) != hipSuccess) { fprintf(stderr, "kernel_launch: hipFuncSetAttribute failed\n"); grid = -1; return; }
        if (hipOccupancyMaxActiveBlocksPerMultiprocessor(&per_cu, (const void*)fwd_kernel, NWAVES * 64, LDS_BYTES) != hipSuccess || per_cu < 1) { fprintf(stderr, "kernel_launch: occupancy query says %d\n", per_cu); per_cu = 1; }
        (void)hipGetLastError();
        grid = cus;
    }
    if (grid < 0) return;
    Args a{};
    for (int i = 0; i < 15; ++i) a.in[i] = (const float*)d_in[i];
    a.out = (float*)d_out; a.ws = (unsigned char*)d_ws;
#if MK_N_LAUNCHES == 1
    a.ph_lo = 0; a.ph_hi = NPHASE;
    void* args[] = {&a};
    hipError_t e = hipLaunchCooperativeKernel((const void*)fwd_kernel, dim3(grid), dim3(NWAVES * 64), args, LDS_BYTES, stream);
    if (e != hipSuccess) fprintf(stderr, "cooperative launch failed: %s (grid %d)\n", hipGetErrorString(e), grid);
#else
    for (int p = 0; p < NPHASE; ++p) { a.ph_lo = p; a.ph_hi = p + 1; hipLaunchKernelGGL(fwd_kernel, dim3(grid), dim3(NWAVES * 64), LDS_BYTES, stream, a); }
#endif
}
```

```cpp
#include <hip/hip_runtime.h>
#include <hip/hip_cooperative_groups.h>
#include <cstdio>
#include <cstdint>
namespace cg = cooperative_groups;

constexpr int DM = 2048, NBATCH = 4, SEQ = 2048, NMETA = 16, LP = 2176, MROWS = NBATCH * LP, DFF = 8192;
constexpr int QKLD = 4096, VTLD = MROWS;
constexpr int LPR = NMETA + SEQ, RVALID = NBATCH * LPR  , MR = 8448  , NQT = (LPR + 31) / 32  ;
constexpr float RMS_EPS = 1e-6f;
constexpr float LOG2E_F = 1.4426950408889634f;

namespace pg8 {
#define PG8_LAS __attribute__((address_space(3)))
typedef unsigned short bf16_t;
typedef short bf16x8 __attribute__((ext_vector_type(8)));
typedef float f32x4 __attribute__((ext_vector_type(4)));
typedef unsigned u32x4 __attribute__((ext_vector_type(4)));
constexpr int BM = 256, BK = 64, HALF = 128, HTB = HALF * BK * 2  , STAGE_BYTES = 8 * HTB, NXCD = 8, WGM = 8;

__host__ __device__ __forceinline__ int lds_byte(int r, int c) { const int st = (r >> 4) * 2 + (c >> 5), rr = r & 15, cc = c & 31, ob = rr * 64 + cc * 2; return st * 1024 + (ob ^ (((ob >> 9) & 1) << 5)); }
__host__ __device__ __forceinline__ void stage_rc(int b, int& R, int& C) { const int st = b / 1024, sb = b % 1024, swz = sb ^ (((sb >> 9) & 1) << 5); R = (st >> 1) * 16 + swz / 64; C = (st & 1) * 32 + (swz % 64) / 2; }
__host__ __device__ __forceinline__ int perm32(int rho) { const int n = rho >> 4, i = rho & 15; return 8 * (i >> 2) + 4 * n + (i & 3); }

struct Unit { int pm, pn, which, k0, nt, part; };
struct Gemm { const bf16_t* A0; const bf16_t* B0; const bf16_t* A1; const bf16_t* B1; int K; };

struct DualOrder {
    int nM0, nN0, n0, nM1, nN1, n1, G, c, ntK;
    __device__ __forceinline__ void init(int M0, int N0, int M1, int N1, int K_, int G_, int c_) { ntK = K_ / BK; nM0 = M0 / BM; nN0 = N0 / BM; n0 = nM0 * nN0; nM1 = M1 / BM; nN1 = N1 / BM; n1 = nM1 * nN1; G = G_; c = c_; }
    __device__ __forceinline__ bool next(int i, Unit& u) const {
        const long L = (long)i * G + c; if (L >= n0 + n1) return false;
        int w = (int)L, nM, nN, nwg; u.k0 = 0; u.nt = ntK; u.part = -1;
        if (w < n0) { u.which = 0; nM = nM0; nN = nN0; nwg = n0; } else { u.which = 1; w -= n0; nM = nM1; nN = nN1; nwg = n1; }
        { const int q = nwg / NXCD, r = nwg % NXCD, xcd = w % NXCD, off = w / NXCD; w = (xcd < r ? xcd * (q + 1) : r * (q + 1) + (xcd - r) * q) + off; }
        const int nig = WGM * nN, gid = w / nig, fm = gid * WGM, gsz = (nM - fm) < WGM ? (nM - fm) : WGM;
        u.pm = fm + ((w % nig) % gsz); u.pn = (w % nig) / gsz; return true;
    }
    __device__ __forceinline__ void a_ready(const Unit&) const {}
    __device__ __forceinline__ void done(const Unit&) const {}
};

template <int lgS> struct TailSplitOrder {
    int G, c, K;
    __device__ __forceinline__ void init(int K_, int G_, int c_) { K = K_; G = G_; c = c_; }
    __device__ __forceinline__ bool next(int i, Unit& u) const {
        u.which = 0; u.pm = 0; u.pn = 0; u.k0 = 0; u.nt = 2; u.part = -1;
        const long L = (long)i * G + c; if (L >= 256 + (8 << lgS)) return false;
        if (L < 256) { int w = (int)L; { const int xcd = w % NXCD, off = w / NXCD; w = xcd * 32 + off; }
            const int nig = WGM * 8, gid = w / nig, fm = gid * WGM; u.pm = fm + ((w % nig) % WGM); u.pn = (w % nig) / WGM; u.k0 = 0; u.nt = K / BK; u.part = -1; }
        else { const int s = (int)L - 256, tile = s >> lgS, part = s & ((1 << lgS) - 1); u.pm = 32; u.pn = tile & 7; u.nt = (K / BK) >> lgS; u.k0 = part * (K >> lgS); u.part = part; }
        return true;
    }
    __device__ __forceinline__ void a_ready(const Unit&) const {}
    __device__ __forceinline__ void done(const Unit&) const {}
};

__device__ __forceinline__ unsigned cvt_pk_bf16(float lo, float hi) { unsigned r; asm volatile("v_cvt_pk_bf16_f32 %0, %1, %2" : "=v"(r) : "v"(lo), "v"(hi)); return r; }


__device__ __forceinline__ float row_ss(const float* ss, int row) {
    const f32x4* p = (const f32x4*)(ss + (size_t)row * 32);
    const f32x4 a = (p[0] + p[1]) + (p[2] + p[3]), b = (p[4] + p[5]) + (p[6] + p[7]), c = a + b;
    return (c[0] + c[1]) + (c[2] + c[3]);
}
struct EpiProj {
    static constexpr bool PERM = true, AFTER_DRAIN = false;
    bf16_t* O0; int ld0; bf16_t* O1; int ld1; const float* ss; const float* ssc; float* kmax; int kc0, kc1;
    __device__ __forceinline__ void operator()(const f32x4 (&acc)[2][2][4][2], const Unit& u, int wr, int wc, int fr, int fq) const {
        const int row0 = u.pm * BM + wr * 64 + fr, col0 = u.pn * BM + wc * 32 + 8 * fq;
        if (u.which == 0) {
            const bool want_k = kmax != nullptr && u.pn * BM >= kc0 && u.pn * BM < kc1;
            float km[2] = {0.f, 0.f};
#pragma unroll
            for (int ai = 0; ai < 2; ++ai)
#pragma unroll
                for (int m = 0; m < 4; ++m) { const int row = row0 + ai * HALF + m * 16; const float rs = rsqrtf((u.pm >= 32 ? row_ss(ss, row) : ssc[row]) * (1.0f / DM) + RMS_EPS);
                    bf16_t* rowp = O0 + (size_t)row * ld0 + col0;
#pragma unroll
                    for (int bj = 0; bj < 2; ++bj) { const f32x4 v0 = acc[ai][bj][m][0] * rs, v1 = acc[ai][bj][m][1] * rs;
                        u32x4 w; w.x = cvt_pk_bf16(v0[0], v0[1]); w.y = cvt_pk_bf16(v0[2], v0[3]); w.z = cvt_pk_bf16(v1[0], v1[1]); w.w = cvt_pk_bf16(v1[2], v1[3]);
                        *(u32x4*)(rowp + bj * HALF) = w;
                        if (want_k) { float q = (v0[0] * v0[0] + v0[1] * v0[1]) + (v0[2] * v0[2] + v0[3] * v0[3]) + (v1[0] * v1[0] + v1[1] * v1[1]) + (v1[2] * v1[2] + v1[3] * v1[3]);
                            q += __shfl_xor(q, 16); q += __shfl_xor(q, 32); km[bj] = fmaxf(km[bj], q); } } }
            if (want_k) {
#pragma unroll
                for (int bj = 0; bj < 2; ++bj) { float q = km[bj];
#pragma unroll
                    for (int o = 1; o < 16; o <<= 1) q = fmaxf(q, __shfl_xor(q, o));
                    if (fr == 0 && fq == 0) atomicMax((unsigned*)kmax + 2 * ((u.pn * BM + bj * HALF + wc * 32 - kc0) >> 6) + (wc & 1), __float_as_uint(q * 1.02f)); }
            }
        } else {
            f32x4 rs[2][2];
#pragma unroll
            for (int bj = 0; bj < 2; ++bj)
#pragma unroll
                for (int n = 0; n < 2; ++n) { const int tk = col0 + bj * HALF + 4 * n; const f32x4 s4 = u.pn >= 32 ? (f32x4){row_ss(ss, tk), row_ss(ss, tk + 1), row_ss(ss, tk + 2), row_ss(ss, tk + 3)} : *(const f32x4*)(ssc + tk);
                    rs[bj][n] = (f32x4){rsqrtf(s4[0] * (1.0f / DM) + RMS_EPS), rsqrtf(s4[1] * (1.0f / DM) + RMS_EPS), rsqrtf(s4[2] * (1.0f / DM) + RMS_EPS), rsqrtf(s4[3] * (1.0f / DM) + RMS_EPS)}; }
#pragma unroll
            for (int ai = 0; ai < 2; ++ai)
#pragma unroll
                for (int m = 0; m < 4; ++m) { const int row = row0 + ai * HALF + m * 16; bf16_t* rowp = O1 + (size_t)row * ld1 + col0;
#pragma unroll
                    for (int bj = 0; bj < 2; ++bj) { const f32x4 v0 = acc[ai][bj][m][0] * rs[bj][0], v1 = acc[ai][bj][m][1] * rs[bj][1];
                        u32x4 w; w.x = cvt_pk_bf16(v0[0], v0[1]); w.y = cvt_pk_bf16(v0[2], v0[3]); w.z = cvt_pk_bf16(v1[0], v1[1]); w.w = cvt_pk_bf16(v1[2], v1[3]);
                        *(u32x4*)(rowp + bj * HALF) = w; } }
        }
    }
};
struct EpiMlpUp {
    static constexpr bool PERM = true, AFTER_DRAIN = false;
    bf16_t* O; int ldc; const float* ss; const float* ssc;
    __device__ __forceinline__ void operator()(const f32x4 (&acc)[2][2][4][2], const Unit& u, int wr, int wc, int fr, int fq) const {
        const int row0 = u.pm * BM + wr * 64 + fr, col0 = u.pn * BM + wc * 32 + 8 * fq;
#pragma unroll
        for (int ai = 0; ai < 2; ++ai)
#pragma unroll
            for (int m = 0; m < 4; ++m) { const int row = row0 + ai * HALF + m * 16; const float rs = rsqrtf((u.pm >= 32 ? row_ss(ss, row) : ssc[row]) * (1.0f / DM) + RMS_EPS);
                bf16_t* rowp = O + (size_t)row * ldc + col0;
#pragma unroll
                for (int bj = 0; bj < 2; ++bj) { f32x4 v0 = acc[ai][bj][m][0] * rs, v1 = acc[ai][bj][m][1] * rs;
#pragma unroll
                    for (int e = 0; e < 4; ++e) { const float a = fmaxf(v0[e], 0.f), b = fmaxf(v1[e], 0.f); v0[e] = a * a; v1[e] = b * b; }
                    u32x4 w; w.x = cvt_pk_bf16(v0[0], v0[1]); w.y = cvt_pk_bf16(v0[2], v0[3]); w.z = cvt_pk_bf16(v1[0], v1[1]); w.w = cvt_pk_bf16(v1[2], v1[3]);
                    *(u32x4*)(rowp + bj * HALF) = w; } }
    }
};
template <int lgS> struct EpiResid {
    static constexpr bool PERM = true, AFTER_DRAIN = false;
    bf16_t* hb; float* ss; float* part;
    __device__ __forceinline__ void operator()(const f32x4 (&acc)[2][2][4][2], const Unit& u, int wr, int wc, int fr, int fq) const {
        if (u.part >= 0) {
            float* pp = part + ((size_t)(((((u.pm - 32) * 8 + u.pn) << lgS) + u.part)) << 16) + (size_t)(wr * 64 + fr) * BM + wc * 32 + 8 * fq;
#pragma unroll
            for (int ai = 0; ai < 2; ++ai)
#pragma unroll
                for (int m = 0; m < 4; ++m)
#pragma unroll
                    for (int bj = 0; bj < 2; ++bj) { float* q = pp + (size_t)(ai * HALF + m * 16) * BM + bj * HALF; *(f32x4*)q = acc[ai][bj][m][0]; *(f32x4*)(q + 4) = acc[ai][bj][m][1]; }
            return;
        }
        const int row0 = u.pm * BM + wr * 64 + fr, col0 = u.pn * BM + wc * 32 + 8 * fq;
#pragma unroll
        for (int ai = 0; ai < 2; ++ai)
#pragma unroll
            for (int m = 0; m < 4; ++m) { const int row = row0 + ai * HALF + m * 16;
                bf16_t* hp = hb + (size_t)row * DM + col0; float part = 0.f;
#pragma unroll
                for (int bj = 0; bj < 2; ++bj) {
                    const u32x4 o = *(const u32x4*)(hp + bj * HALF);
                    f32x4 h0 = {__uint_as_float(o.x << 16), __uint_as_float(o.x & 0xffff0000u), __uint_as_float(o.y << 16), __uint_as_float(o.y & 0xffff0000u)};
                    f32x4 h1 = {__uint_as_float(o.z << 16), __uint_as_float(o.z & 0xffff0000u), __uint_as_float(o.w << 16), __uint_as_float(o.w & 0xffff0000u)};
                    h0 += acc[ai][bj][m][0]; h1 += acc[ai][bj][m][1];
                    part += (h0[0] * h0[0] + h0[1] * h0[1]) + (h0[2] * h0[2] + h0[3] * h0[3]) + (h1[0] * h1[0] + h1[1] * h1[1]) + (h1[2] * h1[2] + h1[3] * h1[3]);
                    u32x4 w; w.x = cvt_pk_bf16(h0[0], h0[1]); w.y = cvt_pk_bf16(h0[2], h0[3]); w.z = cvt_pk_bf16(h1[0], h1[1]); w.w = cvt_pk_bf16(h1[2], h1[3]);
                    *(u32x4*)(hp + bj * HALF) = w; }
                part += __shfl_xor(part, 16); part += __shfl_xor(part, 32);
                if (fq == 0) ss[(size_t)row * 32 + u.pn * 4 + wc] = part; }
    }
};

template <class Epi, class Sched, bool ALIGN_EPI = false, bool SP2 = false>
__device__ __forceinline__ void gemm_phase(PG8_LAS unsigned char* lds, const Gemm g, const Sched& S, const Epi& E) {
    int tid_ = threadIdx.x; asm volatile("" : "+v"(tid_));
    const int tid = tid_, wid = __builtin_amdgcn_readfirstlane(tid >> 6), lane = tid & 63, wr = wid >> 2, wc = wid & 3, fr = lane & 15, fq = lane >> 4;
    const int K = g.K;
    unsigned voffA[2], voffB[2];
#pragma unroll
    for (int i = 0; i < 2; ++i) { int R, C; stage_rc(tid * 16 + i * 8192, R, C); const int Rb = Epi::PERM ? ((R & ~31) + perm32(R & 31)) : R;
        voffA[i] = (unsigned)(R * K + C) * 2u; voffB[i] = (unsigned)(Rb * K + C) * 2u; }
    const size_t kstep = (size_t)(BK * 2);
    const size_t hstep = (size_t)HALF * K * 2;
    const size_t tstep = 2 * hstep;
    const unsigned ldsw = (unsigned)wid * 1024u;
    const int aoff = lds_byte(wr * 64 + fr, fq * 8), boff = lds_byte(wc * 32 + fr, fq * 8);
#define PG8_SA(b, h) (((b) * 2 + (h)) * HTB)
#define PG8_SB(b, h) ((4 + (b) * 2 + (h)) * HTB)
#define PG8_STAGE(bufoff, gbase, voff) do { _Pragma("unroll") for (int _i = 0; _i < 2; ++_i) \
        __builtin_amdgcn_global_load_lds((const unsigned*)((const char*)(gbase) + (voff)[_i]), (PG8_LAS unsigned*)(lds + (bufoff) + ldsw + _i * 8192), 16, 0, 0); } while (0)
#define PG8_LDA(dst, b, h) do { _Pragma("unroll") for (int m = 0; m < 4; ++m) _Pragma("unroll") for (int k = 0; k < 2; ++k) dst[m][k] = *(const PG8_LAS bf16x8*)(lds + PG8_SA(b, h) + aoff + m * 2048 + k * 1024); } while (0)
#define PG8_LDB(dst, b, h) do { _Pragma("unroll") for (int n = 0; n < 2; ++n) _Pragma("unroll") for (int k = 0; k < 2; ++k) dst[n][k] = *(const PG8_LAS bf16x8*)(lds + PG8_SB(b, h) + boff + n * 2048 + k * 1024); } while (0)
#define PG8_MMA(ai, bj, At, Bt) do { __builtin_amdgcn_s_setprio(1); _Pragma("unroll") for (int m = 0; m < 4; ++m) _Pragma("unroll") for (int n = 0; n < 2; ++n) _Pragma("unroll") for (int k = 0; k < 2; ++k) \
        acc[ai][bj][m][n] = __builtin_amdgcn_mfma_f32_16x16x32_bf16(Bt[n][k], At[m][k], acc[ai][bj][m][n], 0, 0, 0); __builtin_amdgcn_s_setprio(0); } while (0)
#define PG8_WAIT_V(n) asm volatile("s_waitcnt vmcnt(" #n ")" ::: "memory")
#define PG8_WAIT_L(n) asm volatile("s_waitcnt lgkmcnt(" #n ")" ::: "memory")
#define PG8_BAR __builtin_amdgcn_s_barrier()
#define PG8_SCHED __builtin_amdgcn_sched_barrier(0)
    Unit cur, nxt; int ui = 0;
    if (!S.next(0, cur)) return;
    f32x4 acc[2][2][4][2];
#pragma unroll
    for (int a = 0; a < 2; ++a)
#pragma unroll
        for (int b = 0; b < 2; ++b)
#pragma unroll
            for (int m = 0; m < 4; ++m)
#pragma unroll
                for (int n = 0; n < 2; ++n) acc[a][b][m][n] = (f32x4){0.f, 0.f, 0.f, 0.f};
    bf16x8 At[4][2], B0[2][2], B1[2][2];
    const char* cA = (const char*)(cur.which ? g.A1 : g.A0) + (size_t)cur.pm * tstep + (size_t)cur.k0 * 2; const char* cB = (const char*)(cur.which ? g.B1 : g.B0) + (size_t)cur.pn * tstep + (size_t)cur.k0 * 2;
    S.a_ready(cur);
    if constexpr (SP2) {
        PG8_STAGE(PG8_SB(0, 0), cB, voffB); PG8_STAGE(PG8_SB(0, 1), cB + hstep, voffB); PG8_STAGE(PG8_SA(0, 0), cA, voffA); PG8_STAGE(PG8_SA(0, 1), cA + hstep, voffA);
        if (wr == 1) PG8_BAR;
        PG8_WAIT_V(2); PG8_BAR;
        PG8_STAGE(PG8_SB(1, 0), cB + kstep, voffB); PG8_STAGE(PG8_SA(1, 0), cA + kstep, voffA); PG8_STAGE(PG8_SB(1, 1), cB + hstep + kstep, voffB);
        PG8_WAIT_V(6); PG8_BAR;
    } else {
        PG8_STAGE(PG8_SB(0, 0), cB, voffB); PG8_STAGE(PG8_SA(0, 0), cA, voffA); PG8_STAGE(PG8_SB(0, 1), cB + hstep, voffB); PG8_STAGE(PG8_SA(0, 1), cA + hstep, voffA);
        if (wr == 1) PG8_BAR;
        PG8_WAIT_V(4); PG8_BAR;
        PG8_STAGE(PG8_SB(1, 0), cB + kstep, voffB); PG8_STAGE(PG8_SA(1, 0), cA + kstep, voffA); PG8_STAGE(PG8_SB(1, 1), cB + hstep + kstep, voffB);
        PG8_WAIT_V(6); PG8_BAR;
    }
    for (;;) {
        const bool has_next = S.next(ui + 1, nxt);
        const char* nA = has_next ? (const char*)(nxt.which ? g.A1 : g.A0) + (size_t)nxt.pm * tstep + (size_t)nxt.k0 * 2 : cA; const char* nB = has_next ? (const char*)(nxt.which ? g.B1 : g.B0) + (size_t)nxt.pn * tstep + (size_t)nxt.k0 * 2 : cB;
        const int nt = cur.nt;
        for (int t = 0; t < nt; t += 2) {
            const bool last = (t == nt - 2);
            const char* a1 = cA + (size_t)(t + 1) * kstep;
            const char* a2 = last ? nA : cA + (size_t)(t + 2) * kstep; const char* b2 = last ? nB : cB + (size_t)(t + 2) * kstep;
            const char* a3 = a2 + kstep; const char* b3 = b2 + kstep;
            if (last && has_next) S.a_ready(nxt);
            if constexpr (SP2) {
            PG8_LDB(B0, 0, 0); PG8_LDB(B1, 0, 1); PG8_SCHED; PG8_LDA(At, 0, 0); PG8_STAGE(PG8_SA(1, 1), a1 + hstep, voffA);
            PG8_WAIT_V(8); PG8_WAIT_L(0); PG8_BAR; PG8_MMA(0, 0, At, B0); PG8_MMA(0, 1, At, B1); PG8_BAR; PG8_SCHED;
            PG8_LDA(At, 0, 1); PG8_STAGE(PG8_SB(0, 0), b2, voffB); PG8_STAGE(PG8_SB(0, 1), b2 + hstep, voffB); PG8_STAGE(PG8_SA(0, 0), a2, voffA);
            PG8_WAIT_V(8); PG8_WAIT_L(0); PG8_BAR; PG8_MMA(1, 0, At, B0); PG8_MMA(1, 1, At, B1); PG8_BAR; PG8_SCHED;
            PG8_LDB(B0, 1, 0); PG8_LDB(B1, 1, 1); PG8_SCHED; PG8_LDA(At, 1, 0); PG8_STAGE(PG8_SA(0, 1), a2 + hstep, voffA);
            PG8_WAIT_V(8); PG8_WAIT_L(0); PG8_BAR; PG8_MMA(0, 0, At, B0); PG8_MMA(0, 1, At, B1); PG8_BAR; PG8_SCHED;
            PG8_LDA(At, 1, 1); PG8_STAGE(PG8_SB(1, 0), b3, voffB); PG8_STAGE(PG8_SB(1, 1), b3 + hstep, voffB); PG8_STAGE(PG8_SA(1, 0), a3, voffA);
            PG8_WAIT_V(8); PG8_WAIT_L(0); PG8_BAR; PG8_MMA(1, 0, At, B0); PG8_MMA(1, 1, At, B1); PG8_BAR; PG8_SCHED;
            } else {
            PG8_LDB(B0, 0, 0); PG8_SCHED; PG8_LDA(At, 0, 0); PG8_STAGE(PG8_SA(1, 1), a1 + hstep, voffA);
            PG8_WAIT_L(8); PG8_BAR; PG8_WAIT_L(0); PG8_MMA(0, 0, At, B0); PG8_BAR; PG8_SCHED;
            PG8_LDB(B1, 0, 1); PG8_STAGE(PG8_SB(0, 0), b2, voffB);
            PG8_BAR; PG8_WAIT_L(0); PG8_MMA(0, 1, At, B1); PG8_BAR;
            PG8_LDA(At, 0, 1); PG8_STAGE(PG8_SA(0, 0), a2, voffA);
            PG8_BAR; PG8_WAIT_L(0); PG8_MMA(1, 0, At, B0); PG8_BAR; PG8_SCHED;
            PG8_STAGE(PG8_SB(0, 1), b2 + hstep, voffB);
            PG8_WAIT_V(6); PG8_BAR; PG8_MMA(1, 1, At, B1); PG8_BAR;
            PG8_LDB(B0, 1, 0); PG8_SCHED; PG8_LDA(At, 1, 0); PG8_STAGE(PG8_SA(0, 1), a2 + hstep, voffA);
            PG8_WAIT_L(8); PG8_BAR; PG8_WAIT_L(0); PG8_MMA(0, 0, At, B0); PG8_BAR; PG8_SCHED;
            PG8_LDB(B1, 1, 1); PG8_STAGE(PG8_SB(1, 0), b3, voffB);
            PG8_BAR; PG8_WAIT_L(0); PG8_MMA(0, 1, At, B1); PG8_BAR;
            PG8_LDA(At, 1, 1); PG8_STAGE(PG8_SA(1, 0), a3, voffA);
            PG8_BAR; PG8_WAIT_L(0); PG8_MMA(1, 0, At, B0); PG8_BAR; PG8_SCHED;
            PG8_STAGE(PG8_SB(1, 1), b3 + hstep, voffB);
            PG8_WAIT_V(6); PG8_BAR; PG8_MMA(1, 1, At, B1); PG8_BAR;
            }
        }
        if constexpr (ALIGN_EPI) { if (wr == 0) PG8_BAR; }
        if constexpr (!Epi::AFTER_DRAIN) { E(acc, cur, wr, wc, fr, fq); S.done(cur); }
        if (!has_next) break;
#pragma unroll
        for (int a = 0; a < 2; ++a)
#pragma unroll
            for (int b = 0; b < 2; ++b)
#pragma unroll
                for (int m = 0; m < 4; ++m)
#pragma unroll
                    for (int n = 0; n < 2; ++n) acc[a][b][m][n] = (f32x4){0.f, 0.f, 0.f, 0.f};
        cur = nxt; cA = nA; cB = nB; ++ui;
        if constexpr (ALIGN_EPI) { if (wr == 1) PG8_BAR; }
    }
    PG8_WAIT_V(0);
    if constexpr (!ALIGN_EPI) { if (wr == 0) PG8_BAR; }
    PG8_BAR;
    if constexpr (Epi::AFTER_DRAIN) { E.fused(acc, cur, wr, wc, fr, fq, lds, wid, lane); S.done(cur); }
#undef PG8_SA
#undef PG8_SB
#undef PG8_STAGE
#undef PG8_LDA
#undef PG8_LDB
#undef PG8_MMA
#undef PG8_WAIT_V
#undef PG8_WAIT_L
#undef PG8_BAR
#undef PG8_SCHED
}
}

namespace att {
using pg8::bf16_t; using pg8::bf16x8;
typedef float f32x16 __attribute__((ext_vector_type(16)));
typedef float f32x4 __attribute__((ext_vector_type(4)));
typedef float f32v2 __attribute__((ext_vector_type(2)));
typedef __bf16 bf16v2 __attribute__((ext_vector_type(2)));
typedef unsigned u32x2 __attribute__((ext_vector_type(2)));
typedef unsigned u32x4 __attribute__((ext_vector_type(4)));
#define MFMA32(a, b, c) __builtin_amdgcn_mfma_f32_32x32x16_bf16((a), (b), (c), 0, 0, 0)
#define NOPACK(x) asm volatile("" : "+v"(x))
constexpr int NT = LP / 32;
constexpr float SC2 = 0.125f * LOG2E_F;
constexpr float NEGB = -1e30f;

__device__ __forceinline__ int chunk_of(int p) { return p < NMETA ? 0 : 1 + ((p - NMETA) >> 6); }
__device__ __forceinline__ unsigned pkbf(float lo, float hi) { f32v2 f = {lo, hi}; bf16v2 b = __builtin_convertvector(f, bf16v2); return __builtin_bit_cast(unsigned, b); }
__device__ __forceinline__ bf16x8 ld8(const bf16_t* p) { return *(const bf16x8*)p; }
template <int S> __device__ __forceinline__ bf16x8 pack8(const f32x16& p) {
    u32x4 w; w.x = pkbf(p[8 * S + 0], p[8 * S + 1]); w.y = pkbf(p[8 * S + 2], p[8 * S + 3]); w.z = pkbf(p[8 * S + 4], p[8 * S + 5]); w.w = pkbf(p[8 * S + 6], p[8 * S + 7]);
    return __builtin_bit_cast(bf16x8, w);
}
__device__ __forceinline__ int key_of_row(int i) { return 16 * (i >> 4) + 8 * ((i >> 2) & 1) + 4 * ((i >> 3) & 1) + (i & 3); }

#define ATTW_LAS __attribute__((address_space(3)))
struct WTile { bf16x8 g[8]; };
__device__ __forceinline__ void wtile_issue(WTile& w, const bf16_t* Kp, const bf16_t* VTp, int key0, int lane) {
#pragma unroll
    for (int i = 0; i < 4; ++i) { const int row = 8 * i + (lane >> 3), pos = lane & 7; w.g[i] = ld8(Kp + (size_t)(key0 + row) * QKLD + ((pos ^ ((row >> 1) & 7)) << 3)); }
#pragma unroll
    for (int i = 0; i < 4; ++i) { const int row = 16 * i + (lane >> 2), pos = lane & 3; w.g[4 + i] = ld8(VTp + (size_t)row * VTLD + key0 + ((pos ^ ((row >> 2) & 3)) << 3)); }
}
__device__ __forceinline__ void wtile_park(const WTile& w, ATTW_LAS unsigned char* W, int lane) {
#pragma unroll
    for (int i = 0; i < 4; ++i) *(ATTW_LAS bf16x8*)(W + (8 * i + (lane >> 3)) * 128 + (lane & 7) * 16) = w.g[i];
#pragma unroll
    for (int i = 0; i < 4; ++i) *(ATTW_LAS bf16x8*)(W + 4096 + (16 * i + (lane >> 2)) * 64 + (lane & 3) * 16) = w.g[4 + i];
}
__device__ __forceinline__ bf16x8 wtile_k(const ATTW_LAS unsigned char* W, int ko, int kk, int hi) { return *(const ATTW_LAS bf16x8*)(W + ko * 128 + (((2 * kk + hi) ^ ((ko >> 1) & 7)) << 4)); }
__device__ __forceinline__ bf16x8 wtile_v(const ATTW_LAS unsigned char* W, int r32, int dt, int ks, int hi) { return *(const ATTW_LAS bf16x8*)(W + 4096 + (32 * dt + r32) * 64 + (((2 * ks + hi) ^ ((r32 >> 2) & 3)) << 4)); }

template <int DV, int MODE>
__device__ __forceinline__ void flash_softmax(const bf16_t* Qp, const bf16_t* Kp, const bf16_t* VTp, int q0, float slope2, float m_init, float l_init,
                                              f32x16 (&o)[DV / 32], float& l_out, int lane, ATTW_LAS unsigned char* W) {
    static_assert(DV == 64, "wave-private staging is laid out for 64 value columns");
    const int r32 = lane & 31, hi = lane >> 5, t = q0 + r32, cq = chunk_of(t);
    bf16x8 qf[4];
#pragma unroll
    for (int kk = 0; kk < 4; ++kk) qf[kk] = ld8(Qp + (size_t)t * QKLD + 16 * kk + 8 * hi);
    const int ko = key_of_row(r32);
#pragma unroll
    for (int dt = 0; dt < DV / 32; ++dt)
#pragma unroll
        for (int r = 0; r < 16; ++r) o[dt][r] = 0.f;
    float m = m_init, l = l_init;
    const int cqmin = chunk_of(q0), cqmax = chunk_of(q0 + 31);
    const int endp = (NMETA + 64 * cqmax) < LP ? (NMETA + 64 * cqmax) : LP;
    const int kt_hi = (endp - 1) >> 5;
    int kt_lo = 0;
    if (MODE == 0) kt_lo = cqmin >= 3 ? ((NMETA + 64 * (cqmin - 3)) >> 5) : 0;
    const float nslope = -slope2;
    int it = (kt_lo > 0 ? kt_lo - 1 : 0);
    WTile w, w1;
    wtile_issue(w, Kp, VTp, (it < kt_lo ? 0 : it) * 32, lane);
    { const int i1 = it < kt_hi ? it + 1 : it; wtile_issue(w1, Kp, VTp, (i1 < kt_lo ? 0 : i1) * 32, lane); }
    for (; it <= kt_hi; ++it) {
        const int key0 = (it < kt_lo ? 0 : it) * 32;
        wtile_park(w, W, lane);
        w = w1;
        const int itn = it + 2 <= kt_hi ? it + 2 : kt_hi;
        wtile_issue(w1, Kp, VTp, (itn < kt_lo ? 0 : itn) * 32, lane);
        f32x16 s;
#pragma unroll
        for (int r = 0; r < 16; ++r) s[r] = 0.f;
#pragma unroll
        for (int kk = 0; kk < 4; ++kk) s = MFMA32(wtile_k(W, ko, kk, hi), qf[kk], s);
        const bool need_mask = (MODE == 0) ? !(key0 >= NMETA && chunk_of(key0 + 31) <= cqmin && chunk_of(key0) + 2 >= cqmax) : (chunk_of(key0 + 31) > cqmin);
        const float tf = (float)(t - key0 - 8 * hi);
        float mx = NEGB;
#pragma unroll
        for (int r = 0; r < 16; ++r) {
            const float dist = fabsf(tf - (float)(16 * (r >> 3) + (r & 7)));
            float v = fmaf(s[r], SC2, nslope * dist);
            if (need_mask) {
                const int kp = key0 + 16 * (r >> 3) + 8 * hi + (r & 7);
                const int ck = chunk_of(kp);
                const bool vis = (MODE == 0) ? ((kp < NMETA) || ((ck <= cq) && (ck + 2 >= cq))) : (ck <= cq);
                v = vis ? v : NEGB;
            }
            s[r] = v; mx = fmaxf(mx, v);
        }
        mx = fmaxf(mx, __shfl_xor(mx, 32));
        if (__any(mx > m + 32.0f)) {
            const float mnew = fmaxf(m, mx), alpha = __builtin_amdgcn_exp2f(m - mnew);
            m = mnew; l *= alpha;
#pragma unroll
            for (int dt = 0; dt < DV / 32; ++dt)
#pragma unroll
                for (int r = 0; r < 16; ++r) { float x = o[dt][r] * alpha; NOPACK(x); o[dt][r] = x; }
        }
        float ps = 0.f;
#pragma unroll
        for (int r = 0; r < 16; ++r) { const float p = __builtin_amdgcn_exp2f(s[r] - m); s[r] = p; ps += p; }
        l += ps;
        const bf16x8 p0 = pack8<0>(s), p1 = pack8<1>(s);
#pragma unroll
        for (int dt = 0; dt < DV / 32; ++dt) { o[dt] = MFMA32(wtile_v(W, r32, dt, 0, hi), p0, o[dt]); o[dt] = MFMA32(wtile_v(W, r32, dt, 1, hi), p1, o[dt]); }
    }
    l_out = l + __shfl_xor(l, 32);
}

#define ATT_LAS __attribute__((address_space(3)))
__device__ __forceinline__ bf16x8 lds8(const ATT_LAS unsigned char* p) { return *(const ATT_LAS bf16x8*)p; }
__device__ __forceinline__ void diff_flash(ATT_LAS unsigned char* L, const bf16_t* qk, const bf16_t* vt, int b, int head, int qb, int tid, int lane, int wave,
                                           float kmax2, ATT_LAS int* votes, f32x16 (&o)[4], float& l_out) {
    const int qsub = wave >> 1, comp = wave & 1, r32 = lane & 31, hi = lane >> 5;
    const size_t rowbase = (size_t)b * LPR;
    const int q0 = 128 * qb + 32 * qsub, t = q0 + r32, cq = chunk_of(t), cqmin = chunk_of(q0);
    const float nslope = -__builtin_amdgcn_exp2f(-0.5f * (float)(head + 1)) * LOG2E_F;
    bf16x8 qf[4];
    { const bf16_t* Qp = qk + (rowbase + t) * QKLD + head * 128 + comp * 64 + 8 * hi;
#pragma unroll
      for (int kk = 0; kk < 4; ++kk) qf[kk] = ld8(Qp + 16 * kk); }
    const int endw = (NMETA + 64 * chunk_of(q0 + 31)) < LP ? (NMETA + 64 * chunk_of(q0 + 31)) : LP, kt_hi = (endw - 1) >> 5;
    const int endb = (NMETA + 64 * chunk_of(128 * qb + 127)) < LP ? (NMETA + 64 * chunk_of(128 * qb + 127)) : LP, nst = (endb + 127) >> 7;
    const int lrow = tid >> 3, lpos = tid & 7, gch = lpos ^ ((lrow >> 1) & 7);
    const bf16_t* gK = qk + (rowbase + lrow) * QKLD + 2048 + head * 128 + gch * 8;
    const int vrow = tid >> 4, vpos = tid & 15, gcv = vpos ^ (vrow & 15);
    const bf16_t* gV = vt + (size_t)(head * 128 + vrow) * VTLD + rowbase + gcv * 8;
    const int wofs = tid * 16;
    const int ko = key_of_row(r32), jk = (ko >> 1) & 7, jv = (r32 >> 1) & 7;
    const int kbase = comp * 16384 + ko * 128, vbase = 32768 + r32 * 256, jv16 = r32 & 15;
#pragma unroll
    for (int dt = 0; dt < 4; ++dt)
#pragma unroll
        for (int r = 0; r < 16; ++r) o[dt][r] = 0.f;
    float m = NEGB, l = 0.f;
    float q2 = 0.f;
#pragma unroll
    for (int kk = 0; kk < 4; ++kk)
#pragma unroll
        for (int e = 0; e < 8; ++e) { const float f = __uint_as_float((unsigned)(unsigned short)qf[kk][e] << 16); q2 += f * f; }
    q2 += __shfl_xor(q2, 32);
    const float bq = sqrtf(q2 * kmax2) * SC2 * 1.001f + 0.01f;
    if (tid < 3) votes[tid] = 0;
    float pre[16];
#pragma unroll
    for (int r = 0; r < 16; ++r) pre[r] = -nslope * (float)(16 * (r >> 3) + (r & 7));
    bf16x8 g[8];
#define DF_LOAD(st) do { const size_t k0_ = (size_t)(st) * 128; g[0] = ld8(gK + k0_ * QKLD); g[1] = ld8(gK + (k0_ + 64) * QKLD); g[2] = ld8(gK + k0_ * QKLD + 64); g[3] = ld8(gK + (k0_ + 64) * QKLD + 64); \
        g[4] = ld8(gV + k0_); g[5] = ld8(gV + (size_t)32 * VTLD + k0_); g[6] = ld8(gV + (size_t)64 * VTLD + k0_); g[7] = ld8(gV + (size_t)96 * VTLD + k0_); } while (0)
#define DF_PARK(st) do { ATT_LAS unsigned char* W_ = L + ((st) & 1) * 65536 + wofs; *(ATT_LAS bf16x8*)(W_) = g[0]; *(ATT_LAS bf16x8*)(W_ + 8192) = g[1]; *(ATT_LAS bf16x8*)(W_ + 16384) = g[2]; *(ATT_LAS bf16x8*)(W_ + 24576) = g[3]; \
        *(ATT_LAS bf16x8*)(W_ + 32768) = g[4]; *(ATT_LAS bf16x8*)(W_ + 40960) = g[5]; *(ATT_LAS bf16x8*)(W_ + 49152) = g[6]; *(ATT_LAS bf16x8*)(W_ + 57344) = g[7]; } while (0)
    DF_LOAD(nst - 1);
    DF_PARK(nst - 1);
    __builtin_amdgcn_s_waitcnt(0);
    __syncthreads();
    for (int s = nst - 1, it = 0; s >= 0; --s, ++it) {
        const bool more = s > 0;
        if (more) DF_LOAD(s - 1);
        const ATT_LAS unsigned char* B = L + (s & 1) * 65536;
#pragma unroll
        for (int sb = 0; sb < 4; ++sb) {
            const int sub = 3 - sb, kt = 4 * s + sub, key0 = kt * 32;
            if (kt <= kt_hi) {
                f32x16 sc;
#pragma unroll
                for (int r = 0; r < 16; ++r) sc[r] = 0.f;
#pragma unroll
                for (int kk = 0; kk < 4; ++kk) { const bf16x8 kf = lds8(B + kbase + sub * 4096 + (((2 * kk + hi) ^ jk) << 4)); sc = MFMA32(kf, qf[kk], sc); }
                const bool far = key0 + 31 <= q0;
                float mx = NEGB, base;
                if (far) {
                    base = -nslope * (float)(key0 + 8 * hi);
#pragma unroll
                    for (int r = 0; r < 16; ++r) { float v = fmaf(sc[r], SC2, pre[r]); NOPACK(v); sc[r] = v; mx = fmaxf(mx, v); }
                } else {
                    const bool need_mask = chunk_of(key0 + 31) > cqmin;
                    const float tf = (float)(t - key0 - 8 * hi);
                    base = -nslope * (float)t;
#pragma unroll
                    for (int r = 0; r < 16; ++r) {
                        const float dist = fabsf(tf - (float)(16 * (r >> 3) + (r & 7)));
                        float v = fmaf(sc[r], SC2, nslope * dist);
                        if (need_mask) { const int kp = key0 + 16 * (r >> 3) + 8 * hi + (r & 7); v = (chunk_of(kp) <= cq) ? v : NEGB; }
                        sc[r] = v; mx = fmaxf(mx, v);
                    }
                }
                mx += base;
                mx = fmaxf(mx, __shfl_xor(mx, 32));
                if (__any(mx > m + 32.0f)) {
                    const float mnew = fmaxf(m, mx), alpha = __builtin_amdgcn_exp2f(m - mnew);
                    m = mnew; l *= alpha;
#pragma unroll
                    for (int dt = 0; dt < 4; ++dt)
#pragma unroll
                        for (int r = 0; r < 16; ++r) { float x = o[dt][r] * alpha; NOPACK(x); o[dt][r] = x; }
                }
                const float mb = m - base;
                float ps = 0.f;
#pragma unroll
                for (int r = 0; r < 16; ++r) { const float p = __builtin_amdgcn_exp2f(sc[r] - mb); sc[r] = p; ps += p; }
                l += ps;
                const bf16x8 p0 = pack8<0>(sc), p1 = pack8<1>(sc);
#pragma unroll
                for (int dt = 0; dt < 4; ++dt) {
                    const bf16x8 v0 = lds8(B + vbase + dt * 8192 + (((sub * 4 + hi) ^ jv16) << 4)), v1 = lds8(B + vbase + dt * 8192 + (((sub * 4 + 2 + hi) ^ jv16) << 4));
                    o[dt] = MFMA32(v0, p0, o[dt]); o[dt] = MFMA32(v1, p1, o[dt]); }
            }
        }
        if (more) DF_PARK(s - 1);
        const bool quit = more && __all((bq - nslope * (float)(128 * s - 1)) - m < -64.0f);
        if (lane == 0 && quit) __hip_atomic_fetch_add(votes + it % 3, 1, __ATOMIC_RELAXED, __HIP_MEMORY_SCOPE_WORKGROUP);
        if (tid == 0) votes[(it + 1) % 3] = 0;
        __syncthreads();
        if (votes[it % 3] == 8) break;
    }
    l_out = l + __shfl_xor(l, 32);
}

#undef DF_LOAD
#undef DF_PARK
__device__ __forceinline__ void flash_stick(const bf16_t* Qp, const bf16_t* Kp, const bf16_t* VTp, int qt, f32x16 (&o)[2], int lane, ATTW_LAS unsigned char* W) {
    const int r32 = lane & 31, hi = lane >> 5, t = 32 * qt + r32;
    bf16x8 qf[4];
#pragma unroll
    for (int kk = 0; kk < 4; ++kk) qf[kk] = ld8(Qp + (size_t)t * QKLD + 16 * kk + 8 * hi);
    const int ko = key_of_row(r32);
#pragma unroll
    for (int dt = 0; dt < 2; ++dt)
#pragma unroll
        for (int r = 0; r < 16; ++r) o[dt][r] = 0.f;
    float R = 0.f;
    WTile w, w1;
    wtile_issue(w, Kp, VTp, qt * 32, lane);
    wtile_issue(w1, Kp, VTp, (qt > 0 ? qt - 1 : 0) * 32, lane);
    for (int kt = qt; kt >= 0; --kt) {
        const int key0 = kt * 32;
        wtile_park(w, W, lane);
        w = w1;
        wtile_issue(w1, Kp, VTp, (kt > 1 ? kt - 2 : 0) * 32, lane);
        f32x16 s;
#pragma unroll
        for (int r = 0; r < 16; ++r) s[r] = 0.f;
#pragma unroll
        for (int kk = 0; kk < 4; ++kk) s = MFMA32(wtile_k(W, ko, kk, hi), qf[kk], s);
        const bool diag = (kt == qt);
        f32x16 lk;
#pragma unroll
        for (int r = 0; r < 16; ++r) {
            const float z = s[r] * SC2, L = __builtin_amdgcn_logf(1.0f + __builtin_amdgcn_exp2f(-fabsf(z)));
            float lsv = fminf(z, 0.f) - L, lkv = fminf(-z, 0.f) - L;
            if (diag) { const int kp = key0 + 16 * (r >> 3) + 8 * hi + (r & 7); const bool strict = kp < t; lsv = strict ? lsv : NEGB; lkv = strict ? lkv : 0.f; }
            s[r] = lsv; lk[r] = lkv;
        }
        f32x16 bt;
        float ta = 0.f, tb = 0.f;
#pragma unroll
        for (int j = 7; j >= 0; --j) { bt[j] = ta; ta += lk[j]; bt[8 + j] = tb; tb += lk[8 + j]; }
        const float pa = __shfl_xor(ta, 32), pb = __shfl_xor(tb, 32);
        const float offB = R + (hi ? 0.f : pb), offA = R + tb + pb + (hi ? 0.f : pa);
#pragma unroll
        for (int j = 0; j < 8; ++j) { s[j] = __builtin_amdgcn_exp2f(s[j] + bt[j] + offA); s[8 + j] = __builtin_amdgcn_exp2f(s[8 + j] + bt[8 + j] + offB); }
        const bf16x8 p0 = pack8<0>(s), p1 = pack8<1>(s);
#pragma unroll
        for (int dt = 0; dt < 2; ++dt) { o[dt] = MFMA32(wtile_v(W, r32, dt, 0, hi), p0, o[dt]); o[dt] = MFMA32(wtile_v(W, r32, dt, 1, hi), p1, o[dt]); }
        R += (ta + tb) + (pa + pb);
        if (__all(R < -64.0f)) break;
    }
}

__device__ __forceinline__ void store_pair16(bf16_t* rowp  , u32x2 a  , u32x2 b  , int hi) {
    typedef unsigned u32v2 __attribute__((ext_vector_type(2)));
    const u32v2 rx = __builtin_amdgcn_permlane32_swap(a.x, b.x, false, false), ry = __builtin_amdgcn_permlane32_swap(a.y, b.y, false, false);
    u32x4 w; w.x = rx[0]; w.y = ry[0]; w.z = rx[1]; w.w = ry[1];
    *(u32x4*)(rowp + 8 * hi) = w;
}
template <int DV>
__device__ __forceinline__ void store_o(const f32x16 (&o)[DV / 32], float scale, bf16_t* dst  , int lane) {
    const int hi = lane >> 5;
#pragma unroll
    for (int dt = 0; dt < DV / 32; ++dt)
#pragma unroll
        for (int gp = 0; gp < 4; gp += 2) {
            u32x2 a, b;
            a.x = pkbf(o[dt][4 * gp] * scale, o[dt][4 * gp + 1] * scale); a.y = pkbf(o[dt][4 * gp + 2] * scale, o[dt][4 * gp + 3] * scale);
            b.x = pkbf(o[dt][4 * gp + 4] * scale, o[dt][4 * gp + 5] * scale); b.y = pkbf(o[dt][4 * gp + 6] * scale, o[dt][4 * gp + 7] * scale);
            store_pair16(dst + 32 * dt + 8 * gp, a, b, hi); }
}
}

#define LAS __attribute__((address_space(3)))
typedef unsigned short bf16;
typedef unsigned v4u __attribute__((ext_vector_type(4)));
typedef float f32x4 __attribute__((ext_vector_type(4)));
constexpr int NWAVES = 8;
constexpr int LDS_BYTES = 147456;
constexpr int LDS_MISC = 131072;
constexpr size_t MiB = 1u << 20;
constexpr size_t WS_CTL = 0;
constexpr size_t WS_SS = 4096, SS_STRIDE = (size_t)MROWS * 4, WS_BAR = 262144;
constexpr size_t WS_WIN0 = 1 * MiB, WS_WOUT0 = 19 * MiB, WS_WMI0 = 27 * MiB, WS_WMO0 = 59 * MiB, WS_WIN1 = 91 * MiB, WS_WOUT1 = 115 * MiB, WS_WMI1 = 123 * MiB, WS_WMO1 = 155 * MiB;
constexpr size_t WS_H = 187 * MiB, WS_XA = 255 * MiB, WS_X = 289 * MiB, WS_QK = WS_X, WS_VT = WS_X + 68 * MiB, WS_ATT = WS_X + 102 * MiB, WS_U = WS_X, WS_PART = 425 * MiB, WS_END = 489 * MiB;
static_assert((size_t)MROWS * DM * 4 == 68 * MiB && (size_t)MROWS * DM * 2 == 34 * MiB && (size_t)MROWS * QKLD * 2 == 68 * MiB && (size_t)MROWS * DFF * 2 == 136 * MiB, "ws map");

__device__ __forceinline__ unsigned f2bf(float f) { unsigned u = __builtin_bit_cast(unsigned, f); return (u + 0x7fffu + ((u >> 16) & 1u)) >> 16; }
__device__ __forceinline__ unsigned pk2(float lo, float hi) { return f2bf(lo) | (f2bf(hi) << 16); }
__device__ __forceinline__ float wave_sum(float v) {
#pragma unroll
    for (int o = 1; o < 64; o <<= 1) v += __shfl_xor(v, o);
    return v;
}
__device__ __forceinline__ void p0_transpose_item(const float* W, int K, int N, bf16* WT, int remap, const float* gain, LAS float* scr, int item, int lane) {
    const int nblk = N / 32, kb = item / nblk, nb = item % nblk, k0 = 64 * kb, n0 = 32 * nb;
    int row_off = 0;
    if (remap) { if (n0 >= 1280 && n0 < 1536) row_off = 2048; else if (n0 >= 1536 && n0 < 3584) row_off = -256; }
    { const int row8 = lane >> 3, c4 = lane & 7;
      f32x4 v[8];
#pragma unroll
      for (int i = 0; i < 8; ++i) v[i] = __builtin_nontemporal_load((const f32x4*)(W + (size_t)(k0 + 8 * i + row8) * N + n0 + 4 * c4));
      if (gain) {
#pragma unroll
        for (int i = 0; i < 8; ++i) v[i] = v[i] * gain[k0 + 8 * i + row8]; }
#pragma unroll
      for (int i = 0; i < 8; ++i) { LAS float* d = scr + (8 * i + row8) * 33 + 4 * c4; d[0] = v[i].x; d[1] = v[i].y; d[2] = v[i].z; d[3] = v[i].w; } }
    asm volatile("s_waitcnt lgkmcnt(0)" ::: "memory");
    const int c = lane & 7;
#pragma unroll
    for (int j = 0; j < 4; ++j) { const int n = (lane >> 3) + 8 * j; const LAS float* s = scr + (8 * c) * 33 + n;
        v4u o; o.x = pk2(s[0 * 33], s[1 * 33]); o.y = pk2(s[2 * 33], s[3 * 33]); o.z = pk2(s[4 * 33], s[5 * 33]); o.w = pk2(s[6 * 33], s[7 * 33]);
        __builtin_nontemporal_store(o, (v4u*)(WT + (size_t)(row_off + n0 + n) * K + k0 + 8 * c)); }
    asm volatile("s_waitcnt lgkmcnt(0)" ::: "memory");
}

#ifndef REP_ATT0
#define REP_ATT0 1
#endif
#ifndef REP_ATT1
#define REP_ATT1 1
#endif
#ifndef REP_P0
#define REP_P0 1
#endif
#define XB_TMO      128
#define XB_XCNT(j)  (256  + 64 * (j))
#define XB_XSUB(j)  (1280 + 64 * (j))
#define XB_XGEN(j)  (2304 + 64 * (j))
#define XB_TOP      3328
#define XB_TOPGEN   3392
#define XCD_BAR_WORDS 3456
#define XB_SPIN_CAP (1u << 18)

__device__ __forceinline__ unsigned xb_ld(unsigned* p)              { return __hip_atomic_load(p, __ATOMIC_RELAXED, __HIP_MEMORY_SCOPE_AGENT); }
__device__ __forceinline__ unsigned xb_add(unsigned* p, unsigned v) { return __hip_atomic_fetch_add(p, v, __ATOMIC_RELAXED, __HIP_MEMORY_SCOPE_AGENT); }
__device__ __forceinline__ unsigned xb_xcc_id() { return (unsigned)__builtin_amdgcn_s_getreg((3 << 11) | 20) & 0xFu; }
#define XB_SPIN(cond, bar) do { unsigned _sp = 0; while (cond) { __builtin_amdgcn_s_sleep(1); \
    if ((++_sp & 255u) == 0u) { if (xb_ld(&(bar)[XB_TMO])) break; if (_sp > XB_SPIN_CAP) { atomicAdd(&(bar)[XB_TMO], 1u); break; } } } } while (0)

struct XcdBarrier {
    unsigned* bar; unsigned x;
    volatile LAS unsigned* st;
};

__device__ __forceinline__ XcdBarrier xcd_barrier_post(unsigned* bar, volatile LAS unsigned* st) {
    XcdBarrier b; b.bar = bar; b.x = xb_xcc_id(); b.st = st;
    if (threadIdx.x == 0) (void)xb_add(&bar[XB_XCNT(b.x)], 1u);
    return b;
}
__device__ __forceinline__ void xcd_barrier_complete(unsigned* bar, unsigned x, unsigned& nloc, unsigned& nx) {
    const unsigned G = gridDim.x * gridDim.y * gridDim.z;
    unsigned sum, cnt, mine, sp = 0u;
    for (;;) {
        sum = 0u; cnt = 0u; mine = 0u;
#pragma unroll
        for (unsigned j = 0; j < 16; ++j) { const unsigned c = xb_ld(&bar[XB_XCNT(j)]); sum += c; cnt += (c > 0u) ? 1u : 0u; mine = (j == x) ? c : mine; }
        if (sum == G) break;
        __builtin_amdgcn_s_sleep(1);
        if ((++sp & 255u) == 0u) { if (xb_ld(&bar[XB_TMO])) break; if (sp > XB_SPIN_CAP) { atomicAdd(&bar[XB_TMO], 1u); break; } }
    }
    nloc = mine > 0u ? mine : 1u; nx = cnt > 0u ? cnt : 1u;
}

__device__ __forceinline__ void xcd_barrier(const XcdBarrier& b) {
    asm volatile("s_waitcnt vmcnt(0)" ::: "memory");
    __syncthreads();
    if (threadIdx.x == 0) {
        unsigned* bar = b.bar;
        __builtin_amdgcn_s_waitcnt(0);
        unsigned nloc = b.st[0], nx = b.st[1];
        if (nloc == 0u) { xcd_barrier_complete(bar, b.x, nloc, nx); b.st[0] = nloc; b.st[1] = nx; }
        const unsigned old = xb_add(&bar[XB_XSUB(b.x)], 1u);
        const unsigned gen = old / nloc;
        if (old + 1u == (gen + 1u) * nloc) {
            __builtin_amdgcn_fence(__ATOMIC_RELEASE, "agent");
            asm volatile("s_waitcnt vmcnt(0)" ::: "memory");
            const unsigned og = xb_add(&bar[XB_TOP], 1u);
            const unsigned tg = og / nx;
            if (og + 1u == (tg + 1u) * nx) xb_add(&bar[XB_TOPGEN], 1u);
            else XB_SPIN(xb_ld(&bar[XB_TOPGEN]) == tg, bar);
            __builtin_amdgcn_fence(__ATOMIC_ACQUIRE, "agent");
            xb_add(&bar[XB_XGEN(b.x)], 1u);
            asm volatile("s_waitcnt vmcnt(0)" ::: "memory");
        } else {
            XB_SPIN(xb_ld(&bar[XB_XGEN(b.x)]) == gen, bar);
            __builtin_amdgcn_fence(__ATOMIC_ACQUIRE, "agent");
            asm volatile("s_waitcnt vmcnt(0)" ::: "memory");
        }
    }
    __syncthreads();
}

__device__ __forceinline__ void pull_convert(int* ctr, const float* W0, int K0, int N0, bf16* T0, int n0, const float* G0, const float* W1, int K1, int N1, bf16* T1, int n1, const float* G1, LAS float* scr, LAS int* slot, int tid, int wave, int lane) {
    asm volatile("" : "+v"(lane));
    for (;;) {
        __syncthreads();
        if (tid == 0) *slot = atomicAdd(ctr, 16);
        __syncthreads();
        const int base = *slot;
        if (base >= n0 + n1) break;
#pragma unroll 1
        for (int j = 0; j < 2; ++j) { const int it = base + wave * 2 + j;
            if (it < n0) p0_transpose_item(W0, K0, N0, T0, 0, G0, scr, it, lane); else if (it < n0 + n1) p0_transpose_item(W1, K1, N1, T1, 0, G1, scr, it - n0, lane); }
    }
}
template <int S>
__device__ __forceinline__ void tail_fixup(bf16* hb, float* ss, float* ssc, const float* part, int gw, int NGW, int lane) {
    asm volatile("" : "+v"(lane));
    for (int r = gw * 64 + lane; r < 8192; r += NGW * 64) ssc[r] = pg8::row_ss(ss, r);
    for (int task = gw; task < 256 * 8; task += NGW) {
        const int rr = task >> 3, pn = task & 7, row = 8192 + rr, tile = pn, r = rr, c = pn * 256 + lane * 4;
        const unsigned long long o = *(const unsigned long long*)(hb + (size_t)row * DM + c);
        f32x4 v = {__uint_as_float((unsigned)o << 16), __uint_as_float((unsigned)o & 0xffff0000u), __uint_as_float((unsigned)(o >> 32) << 16), __uint_as_float((unsigned)(o >> 32) & 0xffff0000u)};
        const float* pp = part + ((size_t)(tile * S) << 16) + (size_t)r * 256 + lane * 4;
#pragma unroll
        for (int p = 0; p < S; ++p) v += *(const f32x4*)(pp + ((size_t)p << 16));
        float s = (v.x * v.x + v.y * v.y) + (v.z * v.z + v.w * v.w);
        *(unsigned long long*)(hb + (size_t)row * DM + c) = (unsigned long long)pk2(v.x, v.y) | ((unsigned long long)pk2(v.z, v.w) << 32);
        s = wave_sum(s);
        if (lane == 0) *(f32x4*)(ss + (size_t)row * 32 + pn * 4) = (f32x4){s, 0.f, 0.f, 0.f};
    }
}
struct Args { const float* in[15]; float* out; unsigned char* ws; int ph_lo, ph_hi; };
constexpr int NPHASE = 12;

__global__ void __launch_bounds__(NWAVES * 64, 2) fwd_kernel(Args a) {
    extern __shared__ __attribute__((aligned(16))) unsigned char lds[];
    cg::grid_group grid = cg::this_grid();
    LAS unsigned char* L = (LAS unsigned char*)lds;
    const int tid = threadIdx.x, lane = tid & 63, wave = __builtin_amdgcn_readfirstlane(tid >> 6);
    const int G = gridDim.x, bx = blockIdx.x;
    unsigned char* ws = a.ws;
    int* ctr = (int*)(ws + WS_CTL);
    float* kmaxw = (float*)(ws + WS_CTL + 2048);
    float* ssc0 = (float*)(ws + WS_SS);
    float* ss0 = (float*)(ws + WS_XA);
    float* ss1 = ss0 + (size_t)MROWS * 32; float* ss2 = ss1 + (size_t)MROWS * 32; float* ss3 = ss2 + (size_t)MROWS * 32; float* ss4 = ss3 + (size_t)MROWS * 32;
    bf16* win0 = (bf16*)(ws + WS_WIN0); bf16* wout0 = (bf16*)(ws + WS_WOUT0); bf16* wmi0 = (bf16*)(ws + WS_WMI0); bf16* wmo0 = (bf16*)(ws + WS_WMO0);
    bf16* win1 = (bf16*)(ws + WS_WIN1); bf16* wout1 = (bf16*)(ws + WS_WOUT1); bf16* wmi1 = (bf16*)(ws + WS_WMI1); bf16* wmo1 = (bf16*)(ws + WS_WMO1);
    bf16* hb = (bf16*)(ws + WS_H);
     bf16* qk = (bf16*)(ws + WS_QK); bf16* vt = (bf16*)(ws + WS_VT); bf16* attb = (bf16*)(ws + WS_ATT); bf16* ub = (bf16*)(ws + WS_U); float* part = (float*)(ws + WS_PART);
    const int lo = a.ph_lo, hi_ph = a.ph_hi;
    constexpr int I_IN0 = (DM / 64) * (4608 / 32), I_OUT = (DM / 64) * (DM / 32), I_MI = (DM / 64) * (DFF / 32), I_MO = (DFF / 64) * (DM / 32), I_IN1 = (DM / 64) * (6144 / 32);
    LAS float* cscr = (LAS float*)(L + wave * 16384);
    volatile LAS unsigned* xst = (volatile LAS unsigned*)(L + LDS_MISC + 64);
    if (tid < 2) xst[tid] = 0u;
    __syncthreads();
    unsigned* barw = (unsigned*)(ws + WS_BAR);
    XcdBarrier xbar; xbar.bar = barw; xbar.x = 0; xbar.st = xst;
#define IN(k) (lo <= (k) && (k) < hi_ph)
#define SEAM(k) do { if (IN(k) && IN((k) + 1)) xcd_barrier(xbar); } while (0)

    if (IN(0)) for (int rep0 = 0; rep0 < REP_P0; ++rep0) {
        LAS float* scr = (LAS float*)(L + wave * 16384);
        const int gw = bx * NWAVES + wave, NGW = G * NWAVES;
        for (int it = gw; it < I_IN0; it += NGW) p0_transpose_item(a.in[3], DM, 4608, win0, 1, a.in[2], scr, it, lane);
        for (int m = gw; m < MR; m += NGW) {
            const int b = m / LPR, t = m % LPR;
            const float* src = m >= RVALID ? nullptr : (t < NMETA ? a.in[1] + (size_t)t * DM : a.in[0] + ((size_t)b * SEQ + (t - NMETA)) * DM);
            float s = 0.f;
#pragma unroll
            for (int j = 0; j < 8; ++j) {
                const int c = (64 * j + lane) * 4;
                f32x4 v = src ? __builtin_nontemporal_load((const f32x4*)(src + c)) : (f32x4){0.f, 0.f, 0.f, 0.f};
                s += (v.x * v.x + v.y * v.y) + (v.z * v.z + v.w * v.w);
                *(unsigned long long*)(hb + (size_t)m * DM + c) = (unsigned long long)pk2(v.x, v.y) | ((unsigned long long)pk2(v.z, v.w) << 32);
            }
            s = wave_sum(s);
            if (lane < 32) ss0[(size_t)m * 32 + lane] = lane == 0 ? s : 0.f;
            if (lane == 0) ssc0[m] = s;
        }
        if (bx == 0 && tid < 64) { ctr[tid] = 0; kmaxw[tid] = 0.f; }
        if (bx == 0) for (int i = tid; i < XCD_BAR_WORDS; i += NWAVES * 64) barw[i] = 0u;
    }
    grid.sync();
    xbar = xcd_barrier_post(barw, xst);

#pragma unroll 1
    for (int layer = 0; layer < 2; ++layer) {
        const int pb = 1 + 5 * layer;
        const float* ss_in = layer == 0 ? ss0 : ss2; float* ss_mid = layer == 0 ? ss1 : ss3; float* ss_out = layer == 0 ? ss2 : ss4;
        const float* ssc_in = ssc0 + (layer == 0 ? 0 : 2) * MROWS; float* ssc_mid = ssc0 + (layer == 0 ? 1 : 3) * MROWS; float* ssc_out = ssc0 + (layer == 0 ? 2 : 4) * MROWS;
        const bf16* w_in = layer == 0 ? win0 : win1; const bf16* w_out = layer == 0 ? wout0 : wout1; const bf16* w_mi = layer == 0 ? wmi0 : wmi1; const bf16* w_mo = layer == 0 ? wmo0 : wmo1;
        const int nqk = layer == 0 ? 3328 : 4096, nv = layer == 0 ? 1280 : 2048;
        if (IN(pb)) {
            pg8::Gemm g{hb, w_in, w_in + (size_t)nqk * DM, hb, DM};
            pg8::DualOrder S; S.init(MR, nqk, nv, MR, DM, G, bx);
            pg8::EpiProj E{qk, QKLD, vt, VTLD, ss_in, ssc_in, layer == 1 ? kmaxw : nullptr, 2048, 4096};
            pg8::gemm_phase<pg8::EpiProj, pg8::DualOrder, true, true>(L, g, S, E);
            if (layer == 0) pull_convert(ctr + 8, a.in[5], DM, DM, wout0, I_OUT, nullptr, a.in[12], DM, DFF, wmi0, I_MI, a.in[11], cscr, (LAS int*)(L + LDS_MISC), tid, wave, lane);
            else pull_convert(ctr + 9, a.in[12] + (size_t)DM * DFF, DM, DFF, wmi1, I_MI, a.in[11] + DM, a.in[10], DM, DM, wout1, I_OUT, nullptr, cscr, (LAS int*)(L + LDS_MISC), tid, wave, lane);
        }
        SEAM(pb);
        if (IN(pb + 1)) for (int rep = 0; rep < (layer == 0 ? REP_ATT0 : REP_ATT1); ++rep) {
            { int t_ = tid; asm volatile("" : "+v"(t_));
              for (int i = bx * 512 + t_; i < (MR - RVALID) * DM / 8; i += G * 512) *(v4u*)(attb + (size_t)RVALID * DM + (size_t)i * 8) = (v4u){0u, 0u, 0u, 0u}; }
            LAS int* s_unit = (LAS int*)(L + LDS_MISC);
            int* q = ctr + layer + 2 * rep;
            if (layer == 0) {
                constexpr int NB = NBATCH * NQT * 2, NA = NB;
                for (;;) {
                    __syncthreads();
                    if (tid == 0) *s_unit = atomicAdd(q, 1);
                    __syncthreads();
                    int u = *s_unit;
                    if (u >= NB + NA) break;
                    int lane = tid & 63; asm volatile("" : "+v"(lane));
                    const bool isB = u < NB; if (!isB) u -= NB;
                    const int qt = NQT - 1 - (u >> 3), rem = u & 7, b = rem >> 1, head = (rem & 1) * 8 + wave;
                    const size_t rowbase = (size_t)b * LPR;
                    const int r32 = lane & 31;
                    const bool real = 32 * qt + r32 < LPR;
                    if (isB) {
                        att::f32x16 o[2];
                        att::flash_stick(qk + rowbase * QKLD + 1280 + head * 64, qk + rowbase * QKLD + 2304 + head * 64, vt + (size_t)(256 + head * 64) * VTLD + rowbase, qt, o, lane, L + wave * 16384);
                        if (real) att::store_o<64>(o, 1.0f, attb + (rowbase + 32 * qt + r32) * DM + 1024 + head * 64, lane);
                    } else {
                        att::f32x16 o[2]; float l;
                        const float slope2 = __builtin_amdgcn_exp2f(-0.5f * (float)(head + 1)) * LOG2E_F, sink2 = a.in[4][head] * LOG2E_F;
                        att::flash_softmax<64, 0>(qk + rowbase * QKLD + head * 64, qk + rowbase * QKLD + 1024 + (head >> 2) * 64, vt + (size_t)((head >> 2) * 64) * VTLD + rowbase, 32 * qt, slope2,
                                                  sink2, (lane >> 5) ? 0.f : 1.f, o, l, lane, L + wave * 16384);
                        if (real) att::store_o<64>(o, 1.0f / l, attb + (rowbase + 32 * qt + r32) * DM + head * 64, lane);
                    }
                }
            } else {
                constexpr int NC = NBATCH * att::NT * 4;
                const float* lv = a.in[8];
                int ln = tid & 63; asm volatile("" : "+v"(ln));
                const float d1 = wave_sum(lv[ln] * lv[64 + ln]), d2 = wave_sum(lv[128 + ln] * lv[192 + ln]);
                const float lambda_init = 0.8f - 0.6f * expf(-0.3f);
                const float lam = expf(d1) - expf(d2) + lambda_init;
                const float* subg = a.in[9];
                for (;;) {
                    __syncthreads();
                    if (tid == 0) *s_unit = atomicAdd(q, 1);
                    __syncthreads();
                    const int u = *s_unit;
                    if (u >= NC) break;
                    int lane = tid & 63; asm volatile("" : "+v"(lane));
                    const int qb = 16 - (u >> 6), rem = u & 63, b = rem >> 4, head = rem & 15, qt = 4 * qb + (wave >> 1), comp = wave & 1;
                    const size_t rowbase = (size_t)b * LPR;
                    const int r32 = lane & 31, hi = lane >> 5;
                    att::f32x16 o[4]; float l;
                    const float kmax2 = kmaxw[4 * head + 2 * (wave & 1)] + kmaxw[4 * head + 2 * (wave & 1) + 1];
                    att::diff_flash(L, qk, vt, b, head, qb, tid, lane, wave, kmax2, (ATT_LAS int*)(L + LDS_MISC + 128), o, l);
                    const float inv = 1.0f / l;
                    LAS float* xch = (LAS float*)(L + (wave >> 1) * 16384);
                    if (comp == 1) {
#pragma unroll
                        for (int dt = 0; dt < 4; ++dt)
#pragma unroll
                            for (int r = 0; r < 16; ++r) xch[(dt * 16 + r) * 64 + lane] = o[dt][r] * inv;
                    }
                    __syncthreads();
                    if (comp == 0 && 32 * qt + r32 < LPR) {
                        float sq = 0.f;
#pragma unroll
                        for (int dt = 0; dt < 4; ++dt)
#pragma unroll
                            for (int r = 0; r < 16; ++r) { const float v = o[dt][r] * inv - lam * xch[(dt * 16 + r) * 64 + lane]; o[dt][r] = v; sq += v * v; }
                        sq += __shfl_xor(sq, 32);
                        const float rn = rsqrtf(sq * (1.0f / 128.0f) + RMS_EPS) * (1.0f - lambda_init);
                        bf16* dst = attb + (rowbase + 32 * qt + r32) * DM + head * 128;
#pragma unroll
                        for (int dt = 0; dt < 4; ++dt)
#pragma unroll
                            for (int gp = 0; gp < 4; gp += 2) { const int d = 32 * dt + 8 * gp + 4 * hi; const f32x4 ga = *(const f32x4*)(subg + d), gb = *(const f32x4*)(subg + d + 8);
                                att::u32x2 wa, wb; wa.x = att::pkbf(o[dt][4 * gp] * rn * ga.x, o[dt][4 * gp + 1] * rn * ga.y); wa.y = att::pkbf(o[dt][4 * gp + 2] * rn * ga.z, o[dt][4 * gp + 3] * rn * ga.w);
                                wb.x = att::pkbf(o[dt][4 * gp + 4] * rn * gb.x, o[dt][4 * gp + 5] * rn * gb.y); wb.y = att::pkbf(o[dt][4 * gp + 6] * rn * gb.z, o[dt][4 * gp + 7] * rn * gb.w);
                                att::store_pair16(dst + 32 * dt + 8 * gp, wa, wb, hi); }
                    }
                }
            }
        }
        SEAM(pb + 1);
        if (IN(pb + 2)) {
            pg8::Gemm g{attb, w_out, attb, w_out, DM};
            pg8::TailSplitOrder<2> S; S.init(DM, G, bx);
            pg8::EpiResid<2> E{hb, ss_mid, part};
            pg8::gemm_phase<pg8::EpiResid<2>, pg8::TailSplitOrder<2>, true, true>(L, g, S, E);
            xcd_barrier(xbar);
            tail_fixup<4>(hb, ss_mid, ssc_mid, part, bx * NWAVES + wave, G * NWAVES, lane);
        }
        SEAM(pb + 2);
        if (IN(pb + 3)) {
            pg8::Gemm g{hb, w_mi, hb, w_mi, DM};
            pg8::DualOrder S; S.init(MR, DFF, 0, 0, DM, G, bx);
            pg8::EpiMlpUp E{ub, DFF, ss_mid, ssc_mid};
            pg8::gemm_phase<pg8::EpiMlpUp, pg8::DualOrder, true, true>(L, g, S, E);
            if (layer == 0) pull_convert(ctr + 12, a.in[13], DFF, DM, wmo0, I_MO, nullptr, a.in[7], DM, 6144, win1, I_IN1, a.in[6], cscr, (LAS int*)(L + LDS_MISC), tid, wave, lane);
            else pull_convert(ctr + 11, a.in[13] + (size_t)DFF * DM, DFF, DM, wmo1, I_MO, nullptr, nullptr, 0, 32, nullptr, 0, nullptr, cscr, (LAS int*)(L + LDS_MISC), tid, wave, lane);
        }
        SEAM(pb + 3);
        if (IN(pb + 4)) {
            pg8::Gemm g{ub, w_mo, ub, w_mo, DFF};
            pg8::TailSplitOrder<3> S; S.init(DFF, G, bx);
            pg8::EpiResid<3> E{hb, ss_out, part};
            pg8::gemm_phase<pg8::EpiResid<3>, pg8::TailSplitOrder<3>, true, true>(L, g, S, E);
            xcd_barrier(xbar);
            tail_fixup<8>(hb, ss_out, ssc_out, part, bx * NWAVES + wave, G * NWAVES, lane);
        }
        SEAM(pb + 4);
    }

    if (IN(11)) {
        const int gw = bx * NWAVES + wave, NGW = G * NWAVES;
        const float* gf = a.in[14];
        for (int r = gw; r < NBATCH * SEQ; r += NGW) {
            const int b = r / SEQ, s = r % SEQ; const size_t m = (size_t)b * LPR + NMETA + s;
            const float rs = rsqrtf((m >= 8192 ? pg8::row_ss(ss4, (int)m) : ssc0[4 * MROWS + m]) * (1.0f / DM) + RMS_EPS);
#pragma unroll
            for (int j = 0; j < 8; ++j) { const int c = (64 * j + lane) * 4; const unsigned long long o = *(const unsigned long long*)(hb + m * DM + c); const f32x4 g = *(const f32x4*)(gf + c);
                const f32x4 v = {__uint_as_float((unsigned)o << 16), __uint_as_float((unsigned)o & 0xffff0000u), __uint_as_float((unsigned)(o >> 32) << 16), __uint_as_float((unsigned)(o >> 32) & 0xffff0000u)};
                __builtin_nontemporal_store(v * rs * g, (f32x4*)(a.out + (size_t)r * DM + c)); }
        }
    }
#undef IN
#undef SEAM
}

#ifndef MK_N_LAUNCHES
#define MK_N_LAUNCHES 1
#endif

extern "C" void kernel_launch(void* const* d_in, const int* in_sizes, int n_in, void* d_out, int out_size, void* d_ws, size_t ws_size, hipStream_t stream) {
    static int grid = 0;
    if (grid == 0) {
        if (n_in != 15 || out_size != NBATCH * SEQ * DM || ws_size < WS_END) { fprintf(stderr, "kernel_launch: unexpected shapes (n_in %d, out %d, ws %zu); nothing launched\n", n_in, out_size, ws_size); grid = -1; return; }
        int dev = 0, cus = 0, per_cu = 0;
        if (hipGetDevice(&dev) != hipSuccess || hipDeviceGetAttribute(&cus, hipDeviceAttributeMultiprocessorCount, dev) != hipSuccess) { grid = -1; return; }
        if (hipFuncSetAttribute((const void*)fwd_kernel, hipFuncAttributeMaxDynamicSharedMemorySize, LDS_BYTES) != hipSuccess) { fprintf(stderr, "kernel_launch: hipFuncSetAttribute failed\n"); grid = -1; return; }
        if (hipOccupancyMaxActiveBlocksPerMultiprocessor(&per_cu, (const void*)fwd_kernel, NWAVES * 64, LDS_BYTES) != hipSuccess || per_cu < 1) { fprintf(stderr, "kernel_launch: occupancy query says %d\n", per_cu); per_cu = 1; }
        (void)hipGetLastError();
        grid = cus;
    }
    if (grid < 0) return;
    Args a{};
    for (int i = 0; i < 15; ++i) a.in[i] = (const float*)d_in[i];
    a.out = (float*)d_out; a.ws = (unsigned char*)d_ws;
#if MK_N_LAUNCHES == 1
    a.ph_lo = 0; a.ph_hi = NPHASE;
    void* args[] = {&a};
    hipError_t e = hipLaunchCooperativeKernel((const void*)fwd_kernel, dim3(grid), dim3(NWAVES * 64), args, LDS_BYTES, stream);
    if (e != hipSuccess) fprintf(stderr, "cooperative launch failed: %s (grid %d)\n", hipGetErrorString(e), grid);
#else
    for (int p = 0; p < NPHASE; ++p) { a.ph_lo = p; a.ph_hi = p + 1; hipLaunchKernelGGL(fwd_kernel, dim3(grid), dim3(NWAVES * 64), LDS_BYTES, stream, a); }
#endif
}
```
